# Optimizing an MI355X kernel written in HIP

```python
import math
import jax, jax.numpy as jnp
from jax import lax
import numpy as np

D_MODEL = 1024
BATCH = 8
SEQ = 8192
DEPTH = 2

GRID_W = 64
CTX_LEN = 256
N_MIXERS = 2
N_SSM_LAYERS = (DEPTH + 1) // 2
N_ATTN_LAYERS = DEPTH // 2
NORM_EPS = 1e-6

SSM_WIDTH = D_MODEL
SSM_GROUP = 16
SSM_GROUPS = SSM_WIDTH // SSM_GROUP
SSM_STATE = 64
DT_MIN = 1e-3
DT_MAX = 1e-1

HEAD_DIM = 64
N_Q_HEADS = D_MODEL // HEAD_DIM
N_KV_HEADS = 4
KV_REP = N_Q_HEADS // N_KV_HEADS
ATTN_WIDTH = N_Q_HEADS * HEAD_DIM
KV_WIDTH = N_KV_HEADS * HEAD_DIM
ATTN_IN = ATTN_WIDTH + 2 * KV_WIDTH + ATTN_WIDTH
Q_BLOCK = 128
ROPE_THETA = 10000.0
ROPE_AXIS_DIM = HEAD_DIM // 2

kernel_name = "hybrid_s5_gqa_prefix_dit"


def _rmsnorm(x, g):
    xf = x.astype(jnp.float32)
    y = xf * lax.rsqrt(jnp.mean(xf * xf, axis=-1, keepdims=True) + NORM_EPS)
    return (y * g.astype(jnp.float32)).astype(x.dtype)


def _rope_tables(L):
    rows = L // GRID_W
    row = jnp.repeat(jnp.arange(rows), GRID_W).astype(jnp.float32)
    col = jnp.tile(jnp.arange(GRID_W), rows).astype(jnp.float32)
    n_freq = ROPE_AXIS_DIM // 2
    freqs = ROPE_THETA ** (-jnp.arange(n_freq, dtype=jnp.float32) / n_freq)
    ang_r = row[:, None] * freqs[None]
    ang_c = col[:, None] * freqs[None]
    return (jnp.cos(ang_r), jnp.sin(ang_r), jnp.cos(ang_c), jnp.sin(ang_c))


def _rope_half(x, cos, sin):
    h = x.shape[-1] // 2
    x1, x2 = x[..., :h], x[..., h:]
    cs, sn = cos[:, None, :], sin[:, None, :]
    return jnp.concatenate([x1 * cs - x2 * sn, x2 * cs + x1 * sn], axis=-1)


def _rope_2d(x, rope):
    cos_r, sin_r, cos_c, sin_c = rope
    xf = x.astype(jnp.float32)
    out = jnp.concatenate([_rope_half(xf[..., :ROPE_AXIS_DIM], cos_r, sin_r),
                           _rope_half(xf[..., ROPE_AXIS_DIM:], cos_c, sin_c)], axis=-1)
    return out.astype(x.dtype)


def _linear_scan(bu, abar, reverse):
    L = bu.shape[1]
    a = jnp.broadcast_to(abar, (1, L) + abar.shape)

    def combine(e_i, e_j):
        a_i, b_i = e_i
        a_j, b_j = e_j
        return a_j * a_i, a_j * b_i + b_j

    _, h = lax.associative_scan(combine, (a, bu), axis=1, reverse=reverse)
    return h


def _s5_core(u_lat, u_ctx, a_re, a_im, log_dt, b_re, b_im, c_re, c_im, d_skip, with_ctx):
    B, L, E = u_lat.shape
    C = u_ctx.shape[1]
    f32 = jnp.float32
    ul = u_lat.astype(f32).reshape(B, L, SSM_GROUPS, SSM_GROUP).astype(jnp.complex64)
    uc = u_ctx.astype(f32).reshape(B, C, SSM_GROUPS, SSM_GROUP).astype(jnp.complex64)
    dsk = d_skip.astype(f32)
    y_lat = u_lat.astype(f32) * dsk
    y_ctx = u_ctx.astype(f32) * dsk if with_ctx else None
    for d in range(2):
        rev = d == 1
        lam = lax.complex(a_re[d].astype(f32), a_im[d].astype(f32))
        lam_dt = lam * jnp.exp(log_dt[d].astype(f32))[:, None]
        abar = jnp.exp(lam_dt)
        bmat = lax.complex(b_re[d].astype(f32), b_im[d].astype(f32))
        bbar = ((abar - 1.0) / lam)[..., None] * bmat
        cmat = lax.complex(c_re[d].astype(f32), c_im[d].astype(f32))
        h_ctx = _linear_scan(jnp.einsum('bcgh,gph->bcgp', uc, bbar), abar, rev)
        h0 = h_ctx[:, 0] if rev else h_ctx[:, -1]
        steps = jnp.arange(L, 0, -1) if rev else jnp.arange(1, L + 1)
        carry = jnp.exp(lam_dt[None] * steps.astype(f32)[:, None, None])
        h_lat = _linear_scan(jnp.einsum('blgh,gph->blgp', ul, bbar), abar, rev) \
            + carry[None] * h0[:, None]
        y_lat = y_lat + jnp.real(jnp.einsum('blgp,ghp->blgh', h_lat, cmat)).reshape(B, L, E)
        if with_ctx:
            y_ctx = y_ctx + jnp.real(jnp.einsum('bcgp,ghp->bcgh', h_ctx, cmat)).reshape(B, C, E)
    return y_lat.astype(u_lat.dtype), (y_ctx.astype(u_ctx.dtype) if with_ctx else None)


def _s5_post(y, z, w_glu, b_glu, w_out):
    y = jax.nn.gelu(y, approximate=False)
    y = y * jax.nn.sigmoid(y @ w_glu + b_glu)
    return (y * jax.nn.silu(z)) @ w_out


def _ssm_layer(h, hc, w_in, a_re, a_im, log_dt, b_re, b_im, c_re, c_im, d_skip,
               w_glu, b_glu, w_out, with_ctx):
    proj = h @ w_in
    u, z = proj[..., :SSM_WIDTH], proj[..., SSM_WIDTH:]
    if with_ctx:
        proj_c = hc @ w_in
        u_c, z_c = proj_c[..., :SSM_WIDTH], proj_c[..., SSM_WIDTH:]
    else:
        u_c = hc @ w_in[:, :SSM_WIDTH]
    y, y_c = _s5_core(u, u_c, a_re, a_im, log_dt, b_re, b_im, c_re, c_im, d_skip, with_ctx)
    out = _s5_post(y, z, w_glu, b_glu, w_out)
    out_c = _s5_post(y_c, z_c, w_glu, b_glu, w_out) if with_ctx else None
    return out, out_c


def _sdpa(qb, k, v):
    s = jnp.einsum('bqgrd,bkgd->bgrqk', qb, k, preferred_element_type=jnp.float32)
    p = jax.nn.softmax(s * (1.0 / math.sqrt(HEAD_DIM)), axis=-1).astype(v.dtype)
    return jnp.einsum('bgrqk,bkgd->bqgrd', p, v)


def _attn_layer(h, hc, w_in, q_norm, k_norm, w_out, rope, with_ctx):
    B, L, _ = h.shape
    C = hc.shape[1]
    proj = h @ w_in
    q = proj[..., :ATTN_WIDTH].reshape(B, L, N_Q_HEADS, HEAD_DIM)
    k = proj[..., ATTN_WIDTH:ATTN_WIDTH + KV_WIDTH].reshape(B, L, N_KV_HEADS, HEAD_DIM)
    v = proj[..., ATTN_WIDTH + KV_WIDTH:ATTN_WIDTH + 2 * KV_WIDTH].reshape(B, L, N_KV_HEADS, HEAD_DIM)
    z = proj[..., ATTN_WIDTH + 2 * KV_WIDTH:]
    q = _rope_2d(_rmsnorm(q, q_norm), rope)
    k = _rope_2d(_rmsnorm(k, k_norm), rope)
    proj_c = hc @ w_in if with_ctx else hc @ w_in[:, ATTN_WIDTH:ATTN_WIDTH + 2 * KV_WIDTH]
    off = ATTN_WIDTH if with_ctx else 0
    k_c = _rmsnorm(proj_c[..., off:off + KV_WIDTH].reshape(B, C, N_KV_HEADS, HEAD_DIM), k_norm)
    v_c = proj_c[..., off + KV_WIDTH:off + 2 * KV_WIDTH].reshape(B, C, N_KV_HEADS, HEAD_DIM)
    k_all = jnp.concatenate([k, k_c], axis=1)
    v_all = jnp.concatenate([v, v_c], axis=1)
    nb = L // Q_BLOCK
    qb = q.reshape(B, nb, Q_BLOCK, N_KV_HEADS, KV_REP, HEAD_DIM).transpose(1, 0, 2, 3, 4, 5)
    o = lax.map(lambda blk: _sdpa(blk, k_all, v_all), qb)
    o = o.transpose(1, 0, 2, 3, 4, 5).reshape(B, L, ATTN_WIDTH)
    out = (o * jax.nn.silu(z)) @ w_out
    out_c = None
    if with_ctx:
        q_c = _rmsnorm(proj_c[..., :ATTN_WIDTH].reshape(B, C, N_Q_HEADS, HEAD_DIM), q_norm)
        o_c = _sdpa(q_c.reshape(B, C, N_KV_HEADS, KV_REP, HEAD_DIM), k_c, v_c).reshape(B, C, ATTN_WIDTH)
        out_c = (o_c * jax.nn.silu(proj_c[..., ATTN_WIDTH + 2 * KV_WIDTH:])) @ w_out
    return out, out_c


def setup_inputs(seed: int = 0) -> dict:
    key = jax.random.key(seed)
    ks = jax.random.split(key, 24)
    f32 = jnp.float32
    nrm = lambda k, shape, s: jax.random.normal(k, shape, f32) * s
    NA, NB, G, P, H = N_SSM_LAYERS, N_ATTN_LAYERS, SSM_GROUPS, SSM_STATE, SSM_GROUP
    a_im0 = jnp.pi * jnp.arange(P, dtype=f32)
    return {
        "x": nrm(ks[0], (BATCH, SEQ, D_MODEL), 1.0),
        "c": nrm(ks[1], (BATCH, D_MODEL), 1.0),
        "ctx": nrm(ks[2], (BATCH, CTX_LEN, D_MODEL), 1.0),
        "c_ctx": nrm(ks[3], (D_MODEL,), 1.0),
        "w_mod": nrm(ks[4], (DEPTH, D_MODEL, 3 * D_MODEL), D_MODEL ** -0.5),
        "b_mod": nrm(ks[5], (DEPTH, 3 * D_MODEL), 0.02),
        "norm_g": 1.0 + nrm(ks[6], (DEPTH, D_MODEL), 0.05),
        "ssm_w_in": nrm(ks[7], (NA, D_MODEL, 2 * SSM_WIDTH), D_MODEL ** -0.5),
        "ssm_a_re": -0.5 + nrm(ks[8], (NA, 2, G, P), 0.01),
        "ssm_a_im": a_im0 + nrm(ks[9], (NA, 2, G, P), 0.01),
        "ssm_log_dt": jax.random.uniform(ks[10], (NA, 2, G), f32,
                                         minval=math.log(DT_MIN), maxval=math.log(DT_MAX)),
        "ssm_b_re": nrm(ks[11], (NA, 2, G, P, H), (2.0 * H) ** -0.5),
        "ssm_b_im": nrm(ks[12], (NA, 2, G, P, H), (2.0 * H) ** -0.5),
        "ssm_c_re": nrm(ks[13], (NA, 2, G, H, P), (2.0 * P) ** -0.5),
        "ssm_c_im": nrm(ks[14], (NA, 2, G, H, P), (2.0 * P) ** -0.5),
        "ssm_d": nrm(ks[15], (NA, SSM_WIDTH), 0.5),
        "ssm_w_glu": nrm(ks[16], (NA, SSM_WIDTH, SSM_WIDTH), SSM_WIDTH ** -0.5),
        "ssm_b_glu": nrm(ks[17], (NA, SSM_WIDTH), 0.02),
        "ssm_w_out": nrm(ks[18], (NA, SSM_WIDTH, D_MODEL), SSM_WIDTH ** -0.5),
        "attn_w_in": nrm(ks[19], (NB, D_MODEL, ATTN_IN), D_MODEL ** -0.5),
        "attn_q_norm": 1.0 + nrm(ks[20], (NB, HEAD_DIM), 0.05),
        "attn_k_norm": 1.0 + nrm(ks[21], (NB, HEAD_DIM), 0.05),
        "attn_w_out": nrm(ks[22], (NB, ATTN_WIDTH, D_MODEL), ATTN_WIDTH ** -0.5),
        "final_norm_g": 1.0 + nrm(ks[23], (D_MODEL,), 0.05),
    }


def reference(x, c, ctx, c_ctx, w_mod, b_mod, norm_g, ssm_w_in, ssm_a_re, ssm_a_im,
              ssm_log_dt, ssm_b_re, ssm_b_im, ssm_c_re, ssm_c_im, ssm_d, ssm_w_glu,
              ssm_b_glu, ssm_w_out, attn_w_in, attn_q_norm, attn_k_norm, attn_w_out,
              final_norm_g):
    L = x.shape[1]
    rope = _rope_tables(L)
    s_c = jax.nn.silu(c)
    s_cc = jax.nn.silu(c_ctx)
    for i in range(DEPTH):
        kind, j = i % N_MIXERS, i // N_MIXERS
        with_ctx = i < DEPTH - 1
        mod = s_c @ w_mod[i] + b_mod[i]
        shift, scale, gate = jnp.split(mod, 3, axis=-1)
        mod_c = s_cc @ w_mod[i] + b_mod[i]
        shift_c, scale_c, gate_c = jnp.split(mod_c, 3, axis=-1)
        h = _rmsnorm(x, norm_g[i]) * (1.0 + scale[:, None]) + shift[:, None]
        hc = _rmsnorm(ctx, norm_g[i]) * (1.0 + scale_c) + shift_c
        if kind == 0:
            out, out_c = _ssm_layer(h, hc, ssm_w_in[j], ssm_a_re[j], ssm_a_im[j], ssm_log_dt[j],
                                    ssm_b_re[j], ssm_b_im[j], ssm_c_re[j], ssm_c_im[j], ssm_d[j],
                                    ssm_w_glu[j], ssm_b_glu[j], ssm_w_out[j], with_ctx)
        else:
            out, out_c = _attn_layer(h, hc, attn_w_in[j], attn_q_norm[j], attn_k_norm[j],
                                     attn_w_out[j], rope, with_ctx)
        x = x + gate[:, None] * out
        if with_ctx:
            ctx = ctx + gate_c * out_c
    return _rmsnorm(x, final_norm_g)
```

```cpp
#include <hip/hip_runtime.h>
#include <hip/hip_cooperative_groups.h>
#include <cstdio>
#include <cstdint>
namespace cg = cooperative_groups;

#define LAS __attribute__((address_space(3)))
typedef _Float16 h16;
typedef _Float16 h16x8 __attribute__((ext_vector_type(8)));
typedef _Float16 h16x2 __attribute__((ext_vector_type(2)));
typedef _Float16 h16x4 __attribute__((ext_vector_type(4)));
typedef float f32x4 __attribute__((ext_vector_type(4)));
typedef float f32x2 __attribute__((ext_vector_type(2)));
typedef float f32x16 __attribute__((ext_vector_type(16)));
typedef unsigned u32x4 __attribute__((ext_vector_type(4)));
typedef unsigned u32x2 __attribute__((ext_vector_type(2)));

constexpr int DM = 1024, NB = 8, SEQ = 8192, CTXL = 256;
constexpr int NTOK = NB * SEQ;
constexpr int NCTX = NB * CTXL;
constexpr int MTOT = NTOK + NCTX;
constexpr int TCH = 32;
constexpr int NCH = MTOT / TCH;
constexpr int NCHP = 2304;
constexpr int UHW = 768;
constexpr int KVL = SEQ + CTXL;
constexpr int NKT = KVL / 64;
constexpr float EPS = 1e-6f;
constexpr float LOG2E = 1.4426950408889634f;
constexpr float QSCALE = 0.125f * LOG2E;

constexpr size_t MiB = 1u << 20;
constexpr size_t WS_MOD = 0;
constexpr size_t WS_BIAS0 = 1 * MiB;
constexpr size_t WS_BIAS1 = 1 * MiB + 512 * 1024;
constexpr size_t WS_ROPEC = 2 * MiB;
constexpr size_t WS_ROPES = 3 * MiB;
constexpr size_t WS_SSQ1 = 4 * MiB;
constexpr size_t WS_SSQ2 = 9 * MiB;
constexpr size_t WS_WGLU = 16 * MiB;
constexpr size_t WS_WOUT0 = 18 * MiB;
constexpr size_t WS_WOUT1 = 20 * MiB;
constexpr size_t WS_W1S = 22 * MiB;
constexpr size_t WS_W2S = 38 * MiB;
constexpr size_t WS_WB0 = 86 * MiB;
constexpr size_t WS_WB1 = 122 * MiB;
constexpr size_t WS_K = 168 * MiB;
constexpr size_t WS_VT = 202 * MiB;
constexpr size_t WS_BUFA = 236 * MiB;
constexpr size_t WS_BUFZ = 368 * MiB;
constexpr size_t WS_UH = 500 * MiB;
constexpr size_t WS_X1 = 716 * MiB;
constexpr size_t WS_END = 980 * MiB;
static_assert(WS_W2S + (size_t)64 * 512 * 768 * 2 <= WS_WB0 && WS_WB0 + (size_t)9 * 2048 * 1024 * 2 <= WS_WB1 && WS_WB1 + (size_t)9 * 2560 * 1024 * 2 <= WS_K, "ws map 1");
static_assert(WS_K + (size_t)32 * KVL * 64 * 2 <= WS_VT && WS_VT + (size_t)32 * KVL * 64 * 2 <= WS_BUFA && WS_BUFA + (size_t)MTOT * DM * 2 <= WS_BUFZ, "ws map 2");
static_assert(WS_BUFZ + (size_t)MTOT * DM * 2 <= WS_UH && WS_UH + (size_t)64 * NCHP * UHW * 2 <= WS_X1 && WS_X1 + (size_t)MTOT * DM * 4 <= WS_END, "ws map 3");
static_assert((size_t)64 * NCHP * 256 * 4 <= (size_t)MTOT * DM * 4, "S fits in X1 region");

constexpr int LDS_BYTES = 147456;

struct Params {
    const float *x, *c, *ctx, *c_ctx, *w_mod, *b_mod, *norm_g, *ssm_w_in, *a_re, *a_im, *log_dt, *b_re, *b_im, *c_re, *c_im, *ssm_d,
        *w_glu, *b_glu, *ssm_w_out, *attn_w_in, *q_norm, *k_norm, *attn_w_out, *final_g;
    float* out;
    unsigned char* ws;
};

__device__ __forceinline__ unsigned pk2(float lo, float hi) { f32x2 v = {lo, hi}; h16x2 h = __builtin_convertvector(v, h16x2); return __builtin_bit_cast(unsigned, h); }
__device__ __forceinline__ u32x4 pk8(f32x4 a, f32x4 b) { u32x4 w; w.x = pk2(a[0], a[1]); w.y = pk2(a[2], a[3]); w.z = pk2(b[0], b[1]); w.w = pk2(b[2], b[3]); return w; }
__device__ __forceinline__ float silu_f(float v) { return v * __builtin_amdgcn_rcpf(1.0f + __expf(-v)); }
__device__ __forceinline__ float sigm_f(float v) { return __builtin_amdgcn_rcpf(1.0f + __expf(-v)); }
__device__ __forceinline__ float wave_sum(float v) {
#pragma unroll
    for (int o = 1; o < 64; o <<= 1) v += __shfl_xor(v, o);
    return v;
}
__device__ __forceinline__ float wave_max(float v) {
#pragma unroll
    for (int o = 1; o < 64; o <<= 1) v = fmaxf(v, __shfl_xor(v, o));
    return v;
}
__device__ __forceinline__ void unpack8(const h16* p, float* f) {
    const h16x8 v = *(const h16x8*)p;
#pragma unroll
    for (int i = 0; i < 8; ++i) f[i] = (float)v[i];
}
__device__ __forceinline__ f32x2 gelu_pk(f32x2 v) {
    const f32x2 av = __builtin_elementwise_abs(v), d = av * 0.2316418882f + 1.0f;
    f32x2 t; t.x = __builtin_amdgcn_rcpf(d.x); t.y = __builtin_amdgcn_rcpf(d.y);
    f32x2 q = t * 0.5307027145f + (-0.7265760135f); q = q * t + 0.7107068705f; q = q * t + (-0.142248368f); q = q * t + 0.127414796f; q = q * t;
    const f32x2 s = (v * v) * (-0.72134752044f);
    f32x2 e; e.x = __builtin_amdgcn_exp2f(s.x); e.y = __builtin_amdgcn_exp2f(s.y);
    const f32x2 m = v * (q * e), r = v - m;
    f32x2 o; o.x = v.x < 0.f ? m.x : r.x; o.y = v.y < 0.f ? m.y : r.y; return o;
}
__device__ __forceinline__ int bsel_of_pm(int pm) { return pm < 256 ? (pm >> 5) : 8; }

namespace pg8 {
constexpr int BM = 256, BK = 64, HALF = 128, HTB = HALF * BK * 2, STAGE_BYTES = 8 * HTB, NXCD = 8, WGM = 8;
__device__ __forceinline__ int lds_byte(int r, int c) { const int st = (r >> 4) * 2 + (c >> 5), rr = r & 15, cc = c & 31, ob = rr * 64 + cc * 2; return st * 1024 + (ob ^ (((ob >> 9) & 1) << 5)); }
__device__ __forceinline__ void stage_rc(int b, int& R, int& C) { const int st = b / 1024, sb = b % 1024, swz = sb ^ (((sb >> 9) & 1) << 5); R = (st >> 1) * 16 + swz / 64; C = (st & 1) * 32 + (swz % 64) / 2; }
__device__ __forceinline__ int perm32(int rho) { const int n = rho >> 4, i = rho & 15; return 8 * (i >> 2) + 4 * n + (i & 3); }

struct Unit { int pm, pn, z; };
struct Gemm { const h16* A; const h16* Bt; int lda, ldb, K; };

struct SchedPlain {
    int nM, nN, nwg, G, c, lda, ldb; size_t bsel_stride;
    __device__ void init(int M, int N, int G_, int c_, int lda_, int ldb_, size_t bs) { nM = M / BM; nN = N / BM; nwg = nM * nN; G = G_; c = c_; lda = lda_; ldb = ldb_; bsel_stride = bs; }
    __device__ __forceinline__ bool next(int i, Unit& u) const {
        const long L = (long)i * G + c; if (L >= nwg) return false;
        int wgid = (int)L; { const int q = nwg / NXCD, r = nwg % NXCD, xcd = wgid % NXCD, off = wgid / NXCD; wgid = (xcd < r ? xcd * (q + 1) : r * (q + 1) + (xcd - r) * q) + off; }
        const int nig = WGM * nN, gid = wgid / nig, fm = gid * WGM, gsz = (nM - fm) < WGM ? (nM - fm) : WGM;
        u.pm = fm + ((wgid % nig) % gsz); u.pn = (wgid % nig) / gsz; u.z = 0; return true;
    }
    __device__ __forceinline__ size_t a_off(const Unit& u) const { return (size_t)u.pm * BM * lda; }
    __device__ __forceinline__ size_t b_off(const Unit& u) const { return (bsel_stride ? (size_t)bsel_of_pm(u.pm) * bsel_stride : 0) + (size_t)u.pn * BM * ldb; }
};
struct SchedGrouped {
    int nM, nN, nz, G, c, lda, ldb; size_t a_gs, b_gs;
    __device__ void init(int M, int N, int nz_, int G_, int c_, int lda_, int ldb_, size_t ags, size_t bgs) { nM = M / BM; nN = N / BM; nz = nz_; G = G_; c = c_; lda = lda_; ldb = ldb_; a_gs = ags; b_gs = bgs; }
    __device__ __forceinline__ bool next(int i, Unit& u) const {
        const long L = (long)i * G + c; const int per = nM * nN; if (L >= (long)nz * per) return false;
        u.z = (int)(L / per); const int t = (int)(L % per); u.pn = t / nM; u.pm = t % nM; return true;
    }
    __device__ __forceinline__ size_t a_off(const Unit& u) const { return (size_t)u.z * a_gs + (size_t)u.pm * BM * lda; }
    __device__ __forceinline__ size_t b_off(const Unit& u) const { return (size_t)u.z * b_gs + (size_t)u.pn * BM * ldb; }
};

template <class Epi, class Sched>
__device__ __forceinline__ void gemm_phase(LAS unsigned char* lds, const Gemm g, const Sched& S, const Epi& E) {
    int tid = threadIdx.x; asm volatile("" : "+v"(tid));
    const int wid = __builtin_amdgcn_readfirstlane(tid >> 6), lane = tid & 63, wr = wid >> 2, wc = wid & 3, fr = lane & 15, fq = lane >> 4;
    const int K = g.K, nt = K / BK;
    unsigned voffA[2], voffB[2];
#pragma unroll
    for (int i = 0; i < 2; ++i) { int R, C; stage_rc(tid * 16 + i * 8192, R, C); const int Rb = (R & ~31) + perm32(R & 31);
        voffA[i] = (unsigned)(R * g.lda + C) * 2u; voffB[i] = (unsigned)(Rb * g.ldb + C) * 2u; }
    const size_t kstep = (size_t)(BK * 2);
    const size_t hsA = (size_t)HALF * g.lda * 2, hsB = (size_t)HALF * g.ldb * 2;
    const unsigned ldsw = (unsigned)wid * 1024u;
    const int aoff = lds_byte(wr * 64 + fr, fq * 8), boff = lds_byte(wc * 32 + fr, fq * 8);
#define PG8_SA(b, h) (((b) * 2 + (h)) * HTB)
#define PG8_SB(b, h) ((4 + (b) * 2 + (h)) * HTB)
#define PG8_STAGE(bufoff, gbase, voff) do { _Pragma("unroll") for (int _i = 0; _i < 2; ++_i) \
        __builtin_amdgcn_global_load_lds((const unsigned*)((const char*)(gbase) + (voff)[_i]), (LAS unsigned*)(lds + (bufoff) + ldsw + _i * 8192), 16, 0, 0); } while (0)
#define PG8_LDA(dst, b, h) do { _Pragma("unroll") for (int m = 0; m < 4; ++m) _Pragma("unroll") for (int k = 0; k < 2; ++k) dst[m][k] = *(const LAS h16x8*)(lds + PG8_SA(b, h) + aoff + m * 2048 + k * 1024); } while (0)
#define PG8_LDB(dst, b, h) do { _Pragma("unroll") for (int n = 0; n < 2; ++n) _Pragma("unroll") for (int k = 0; k < 2; ++k) dst[n][k] = *(const LAS h16x8*)(lds + PG8_SB(b, h) + boff + n * 2048 + k * 1024); } while (0)
#define PG8_MMA(ai, bj, At, Bt) do { __builtin_amdgcn_s_setprio(1); _Pragma("unroll") for (int m = 0; m < 4; ++m) _Pragma("unroll") for (int n = 0; n < 2; ++n) _Pragma("unroll") for (int k = 0; k < 2; ++k) \
        acc[ai][bj][m][n] = __builtin_amdgcn_mfma_f32_16x16x32_f16(Bt[n][k], At[m][k], acc[ai][bj][m][n], 0, 0, 0); __builtin_amdgcn_s_setprio(0); } while (0)
#define PG8_WAIT_V(n) asm volatile("s_waitcnt vmcnt(" #n ")" ::: "memory")
#define PG8_WAIT_L(n) asm volatile("s_waitcnt lgkmcnt(" #n ")" ::: "memory")
#define PG8_BAR __builtin_amdgcn_s_barrier()
#define PG8_SCHED __builtin_amdgcn_sched_barrier(0)
    Unit cur, nxt; int ui = 0;
    if (!S.next(0, cur)) return;
    f32x4 acc[2][2][4][2];
#pragma unroll
    for (int a = 0; a < 2; ++a)
#pragma unroll
        for (int b = 0; b < 2; ++b)
#pragma unroll
            for (int m = 0; m < 4; ++m)
#pragma unroll
                for (int n = 0; n < 2; ++n) acc[a][b][m][n] = (f32x4){0.f, 0.f, 0.f, 0.f};
    h16x8 At[4][2], B0[2][2], B1[2][2];
    const char* cA = (const char*)g.A + S.a_off(cur) * 2; const char* cB = (const char*)g.Bt + S.b_off(cur) * 2;
    PG8_STAGE(PG8_SB(0, 0), cB, voffB); PG8_STAGE(PG8_SB(0, 1), cB + hsB, voffB); PG8_STAGE(PG8_SA(0, 0), cA, voffA); PG8_STAGE(PG8_SA(0, 1), cA + hsA, voffA);
    if (wr == 1) PG8_BAR;
    PG8_WAIT_V(2); PG8_BAR;
    PG8_STAGE(PG8_SB(1, 0), cB + kstep, voffB); PG8_STAGE(PG8_SA(1, 0), cA + kstep, voffA); PG8_STAGE(PG8_SB(1, 1), cB + hsB + kstep, voffB);
    PG8_WAIT_V(6); PG8_BAR;
    for (;;) {
        const bool has_next = S.next(ui + 1, nxt);
        const char* nA = has_next ? (const char*)g.A + S.a_off(nxt) * 2 : cA; const char* nB = has_next ? (const char*)g.Bt + S.b_off(nxt) * 2 : cB;
        for (int t = 0; t < nt; t += 2) {
            const bool last = (t == nt - 2);
            const char* a1 = cA + (size_t)(t + 1) * kstep;
            const char* a2 = last ? nA : cA + (size_t)(t + 2) * kstep; const char* b2 = last ? nB : cB + (size_t)(t + 2) * kstep;
            const char* a3 = a2 + kstep; const char* b3 = b2 + kstep;
            PG8_LDB(B0, 0, 0); PG8_LDB(B1, 0, 1); PG8_SCHED; PG8_LDA(At, 0, 0); PG8_STAGE(PG8_SA(1, 1), a1 + hsA, voffA);
            PG8_WAIT_V(8); PG8_WAIT_L(0); PG8_BAR; PG8_MMA(0, 0, At, B0); PG8_MMA(0, 1, At, B1); PG8_BAR; PG8_SCHED;
            PG8_LDA(At, 0, 1); PG8_STAGE(PG8_SB(0, 0), b2, voffB); PG8_STAGE(PG8_SB(0, 1), b2 + hsB, voffB); PG8_STAGE(PG8_SA(0, 0), a2, voffA);
            PG8_WAIT_V(8); PG8_WAIT_L(0); PG8_BAR; PG8_MMA(1, 0, At, B0); PG8_MMA(1, 1, At, B1); PG8_BAR; PG8_SCHED;
            PG8_LDB(B0, 1, 0); PG8_LDB(B1, 1, 1); PG8_SCHED; PG8_LDA(At, 1, 0); PG8_STAGE(PG8_SA(0, 1), a2 + hsA, voffA);
            PG8_WAIT_V(8); PG8_WAIT_L(0); PG8_BAR; PG8_MMA(0, 0, At, B0); PG8_MMA(0, 1, At, B1); PG8_BAR; PG8_SCHED;
            PG8_LDA(At, 1, 1); PG8_STAGE(PG8_SB(1, 0), b3, voffB); PG8_STAGE(PG8_SB(1, 1), b3 + hsB, voffB); PG8_STAGE(PG8_SA(1, 0), a3, voffA);
            PG8_WAIT_V(8); PG8_WAIT_L(0); PG8_BAR; PG8_MMA(1, 0, At, B0); PG8_MMA(1, 1, At, B1); PG8_BAR; PG8_SCHED;
        }
        if (wr == 0) PG8_BAR;
        E(acc, cur, wr, wc, fr, fq);
        if (!has_next) break;
#pragma unroll
        for (int a = 0; a < 2; ++a)
#pragma unroll
            for (int b = 0; b < 2; ++b)
#pragma unroll
                for (int m = 0; m < 4; ++m)
#pragma unroll
                    for (int n = 0; n < 2; ++n) acc[a][b][m][n] = (f32x4){0.f, 0.f, 0.f, 0.f};
        cur = nxt; cA = nA; cB = nB; ++ui;
        if (wr == 1) PG8_BAR;
    }
    PG8_WAIT_V(0);
    PG8_BAR;
#undef PG8_SA
#undef PG8_SB
#undef PG8_STAGE
#undef PG8_LDA
#undef PG8_LDB
#undef PG8_MMA
#undef PG8_WAIT_V
#undef PG8_WAIT_L
#undef PG8_BAR
#undef PG8_SCHED
}
}

typedef f32x4 AccT[2][2][4][2];

struct EpiSsmIn {
    h16* UH; h16* Z;
    __device__ __forceinline__ void operator()(const AccT& acc, const pg8::Unit& u, int wr, int wc, int fr, int fq) const {
        const int cw = wc * 32 + 8 * fq;
#pragma unroll
        for (int ai = 0; ai < 2; ++ai)
#pragma unroll
            for (int m = 0; m < 4; ++m) {
                const int row = u.pm * 256 + ai * 128 + wr * 64 + m * 16 + fr;
#pragma unroll
                for (int bj = 0; bj < 2; ++bj) {
                    f32x4 v0 = acc[ai][bj][m][0], v1 = acc[ai][bj][m][1];
                    const int col = u.pn * 256 + bj * 128 + cw;
                    if (u.pn < 4) {
                        const int g = col >> 4, h0 = col & 15, cr = row >> 5, s = row & 31;
                        *(u32x4*)(UH + ((size_t)(g * NCHP + cr) * UHW + s * 16 + h0)) = pk8(v0, v1);
                    } else {
#pragma unroll
                        for (int e = 0; e < 4; ++e) { v0[e] = silu_f(v0[e]); v1[e] = silu_f(v1[e]); }
                        *(u32x4*)(Z + ((size_t)row * DM + (col - 1024))) = pk8(v0, v1);
                    }
                }
            }
    }
};
struct EpiS5State {
    float* S;
    __device__ __forceinline__ void operator()(const AccT& acc, const pg8::Unit& u, int wr, int wc, int fr, int fq) const {
#pragma unroll
        for (int ai = 0; ai < 2; ++ai)
#pragma unroll
            for (int m = 0; m < 4; ++m) {
                const int row = u.pm * 256 + ai * 128 + wr * 64 + m * 16 + fr;
                float* rp = S + ((size_t)(u.z * NCHP + row) * 256 + wc * 32 + 8 * fq);
#pragma unroll
                for (int bj = 0; bj < 2; ++bj) { *(f32x4*)(rp + bj * 128) = acc[ai][bj][m][0]; *(f32x4*)(rp + bj * 128 + 4) = acc[ai][bj][m][1]; }
            }
    }
};
struct EpiS5Out {
    h16* Y1;
    __device__ __forceinline__ void operator()(const AccT& acc, const pg8::Unit& u, int wr, int wc, int fr, int fq) const {
#pragma unroll
        for (int ai = 0; ai < 2; ++ai)
#pragma unroll
            for (int m = 0; m < 4; ++m) {
                const int cr = u.pm * 256 + ai * 128 + wr * 64 + m * 16 + fr;
                if (cr < NCH) {
#pragma unroll
                    for (int bj = 0; bj < 2; ++bj) {
                        const int n = u.pn * 256 + bj * 128 + wc * 32 + 8 * fq; const int s = n >> 4, h0 = n & 15;
                        const f32x4 a = acc[ai][bj][m][0], b = acc[ai][bj][m][1];
                        const f32x2 g0 = gelu_pk((f32x2){a[0], a[1]}), g1 = gelu_pk((f32x2){a[2], a[3]}), g2 = gelu_pk((f32x2){b[0], b[1]}), g3 = gelu_pk((f32x2){b[2], b[3]});
                        u32x4 w; w.x = pk2(g0.x, g0.y); w.y = pk2(g1.x, g1.y); w.z = pk2(g2.x, g2.y); w.w = pk2(g3.x, g3.y);
                        *(u32x4*)(Y1 + ((size_t)(cr * TCH + s) * DM + u.z * 16 + h0)) = w;
                    }
                }
            }
    }
};
struct EpiGlu {
    const h16* Y1; const h16* Z; const float* bglu; h16* G2;
    __device__ __forceinline__ void operator()(const AccT& acc, const pg8::Unit& u, int wr, int wc, int fr, int fq) const {
        const int cw = u.pn * 256 + wc * 32 + 8 * fq;
        f32x4 bv[2][2];
#pragma unroll
        for (int bj = 0; bj < 2; ++bj)
#pragma unroll
            for (int n = 0; n < 2; ++n) bv[bj][n] = *(const f32x4*)(bglu + cw + bj * 128 + 4 * n);
#pragma unroll
        for (int ai = 0; ai < 2; ++ai)
#pragma unroll
            for (int m = 0; m < 4; ++m) {
                const int row = u.pm * 256 + ai * 128 + wr * 64 + m * 16 + fr;
#pragma unroll
                for (int bj = 0; bj < 2; ++bj) {
                    const size_t off = (size_t)row * DM + cw + bj * 128;
                    float y[8], z[8]; unpack8(Y1 + off, y); unpack8(Z + off, z);
                    f32x4 v0 = acc[ai][bj][m][0] + bv[bj][0], v1 = acc[ai][bj][m][1] + bv[bj][1];
#pragma unroll
                    for (int e = 0; e < 4; ++e) { v0[e] = y[e] * sigm_f(v0[e]) * z[e]; v1[e] = y[4 + e] * sigm_f(v1[e]) * z[4 + e]; }
                    *(u32x4*)(G2 + off) = pk8(v0, v1);
                }
            }
    }
};
template <bool IN16>
struct EpiOut {
    const float* xin; const float* xin_ctx; const h16* xin16; const float* gate;   h16* xout16; h16* xh; const float* xhf;   float* ssq;
    __device__ __forceinline__ void operator()(const AccT& acc, const pg8::Unit& u, int wr, int wc, int fr, int fq) const {
        const int bs = bsel_of_pm(u.pm); const int cw = u.pn * 256 + wc * 32 + 8 * fq;
        const float* gp = gate + bs * 3072 + cw;
#pragma unroll
        for (int ai = 0; ai < 2; ++ai)
#pragma unroll
            for (int m = 0; m < 4; ++m) {
                const int row = u.pm * 256 + ai * 128 + wr * 64 + m * 16 + fr;
                float sq = 0.f;
#pragma unroll
                for (int bj = 0; bj < 2; ++bj) {
                    const int col = cw + bj * 128;
                    const f32x4 g0 = *(const f32x4*)(gp + bj * 128), g1 = *(const f32x4*)(gp + bj * 128 + 4);
                    f32x4 x0, x1;
                    if (IN16) { float xv[8]; unpack8(xin16 + (size_t)row * DM + col, xv); x0 = (f32x4){xv[0], xv[1], xv[2], xv[3]}; x1 = (f32x4){xv[4], xv[5], xv[6], xv[7]}; }
                    else { const float* xr = (row < NTOK) ? xin + (size_t)row * DM : xin_ctx + (size_t)(row - NTOK) * DM; x0 = *(const f32x4*)(xr + col); x1 = *(const f32x4*)(xr + col + 4); }
                    const f32x4 o0 = x0 + g0 * acc[ai][bj][m][0], o1 = x1 + g1 * acc[ai][bj][m][1];
                    *(u32x4*)(xout16 + (size_t)row * DM + col) = pk8(o0, o1);
                    if (xh) { const f32x4 f0 = *(const f32x4*)(xhf + bs * 1024 + col), f1 = *(const f32x4*)(xhf + bs * 1024 + col + 4); *(u32x4*)(xh + (size_t)row * DM + col) = pk8(o0 * f0, o1 * f1); }
#pragma unroll
                    for (int e = 0; e < 4; ++e) sq += o0[e] * o0[e] + o1[e] * o1[e];
                }
                sq += __shfl_xor(sq, 16); sq += __shfl_xor(sq, 32);
                if (fq == 0) ssq[(size_t)row * 16 + u.pn * 4 + wc] = sq;
            }
    }
};
struct EpiAttnIn {
    const float* ssq; const float* bias; const float* qn; const float* kn; const float* ropec; const float* ropes;
    h16* Q; h16* Kb; h16* Vt; h16* Z;
    __device__ __forceinline__ void operator()(const AccT& acc, const pg8::Unit& u, int wr, int wc, int fr, int fq) const {
        const int bs = bsel_of_pm(u.pm); const int cw = wc * 32 + 8 * fq;
        const float* bp = bias + bs * 2560 + u.pn * 256 + cw;
        const bool is_ctx = (u.pm >= 256);
        if (is_ctx && (u.pn < 4 || u.pn >= 6)) return;
        f32x4 bv[2][2];
#pragma unroll
        for (int bj = 0; bj < 2; ++bj)
#pragma unroll
            for (int n = 0; n < 2; ++n) bv[bj][n] = *(const f32x4*)(bp + bj * 128 + 4 * n);
        if (u.pn < 5) {
            const float* nwp = (u.pn < 4) ? qn : kn;
            const int dlo = 32 * (fq >> 1) + 8 * (fq & 1);
            f32x4 nw[2][2];
#pragma unroll
            for (int bj = 0; bj < 2; ++bj)
#pragma unroll
                for (int n = 0; n < 2; ++n) nw[bj][n] = *(const f32x4*)(nwp + dlo + 16 * bj + 4 * n);
            const float osc = (u.pn < 4) ? QSCALE : 1.0f;
#pragma unroll
            for (int ai = 0; ai < 2; ++ai)
#pragma unroll
                for (int m = 0; m < 4; ++m) {
                    const int row = u.pm * 256 + ai * 128 + wr * 64 + m * 16 + fr;
                    const f32x4 s0 = *(const f32x4*)(ssq + (size_t)row * 16), s1 = *(const f32x4*)(ssq + (size_t)row * 16 + 4), s2 = *(const f32x4*)(ssq + (size_t)row * 16 + 8), s3 = *(const f32x4*)(ssq + (size_t)row * 16 + 12);
                    const f32x4 st = (s0 + s1) + (s2 + s3);
                    const float rstd = __builtin_amdgcn_rsqf(((st[0] + st[1]) + (st[2] + st[3])) * (1.0f / 1024.0f) + EPS);
                    f32x4 v[2][2]; float sq = 0.f;
#pragma unroll
                    for (int bj = 0; bj < 2; ++bj)
#pragma unroll
                        for (int n = 0; n < 2; ++n) { v[bj][n] = acc[ai][bj][m][n] * rstd + bv[bj][n];
#pragma unroll
                            for (int e = 0; e < 4; ++e) sq += v[bj][n][e] * v[bj][n][e]; }
                    sq += __shfl_xor(sq, 16); sq += __shfl_xor(sq, 32);
                    const float rn = __builtin_amdgcn_rsqf(sq * (1.0f / 64.0f) + EPS) ;
                    f32x4 o[2][2];
                    if (!is_ctx) {
                        const int t = row & (SEQ - 1); const int pos = (fq >> 1) ? (t & 63) : (t >> 6);
                        const float* cp = ropec + pos * 16 + 8 * (fq & 1); const float* sp = ropes + pos * 16 + 8 * (fq & 1);
#pragma unroll
                        for (int n = 0; n < 2; ++n) {
                            const f32x4 cs = *(const f32x4*)(cp + 4 * n), sn = *(const f32x4*)(sp + 4 * n);
                            const f32x4 x1 = v[0][n] * rn * nw[0][n], x2 = v[1][n] * rn * nw[1][n];
                            o[0][n] = (x1 * cs - x2 * sn) * osc; o[1][n] = (x2 * cs + x1 * sn) * osc;
                        }
                    } else {
#pragma unroll
                        for (int n = 0; n < 2; ++n) { o[0][n] = v[0][n] * rn * nw[0][n]; o[1][n] = v[1][n] * rn * nw[1][n]; }
                    }
                    if (u.pn < 4) {
                        h16* qp = Q + (size_t)row * DM + (4 * u.pn + wc) * 64 + dlo;
                        *(u32x4*)(qp) = pk8(o[0][0], o[0][1]); *(u32x4*)(qp + 16) = pk8(o[1][0], o[1][1]);
                    } else {
                        int b, key; if (!is_ctx) { b = row >> 13; key = row & (SEQ - 1); } else { const int rc = row - NTOK; b = rc >> 8; key = SEQ + (rc & 255); }
                        h16* kp = Kb + ((size_t)((b * 4 + wc) * KVL + key)) * 64 + dlo;
                        *(u32x4*)(kp) = pk8(o[0][0], o[0][1]); *(u32x4*)(kp + 16) = pk8(o[1][0], o[1][1]);
                    }
                }
        } else {
#pragma unroll
            for (int ai = 0; ai < 2; ++ai)
#pragma unroll
                for (int m = 0; m < 4; ++m) {
                    const int row = u.pm * 256 + ai * 128 + wr * 64 + m * 16 + fr;
                    const f32x4 s0 = *(const f32x4*)(ssq + (size_t)row * 16), s1 = *(const f32x4*)(ssq + (size_t)row * 16 + 4), s2 = *(const f32x4*)(ssq + (size_t)row * 16 + 8), s3 = *(const f32x4*)(ssq + (size_t)row * 16 + 12);
                    const f32x4 st = (s0 + s1) + (s2 + s3);
                    const float rstd = __builtin_amdgcn_rsqf(((st[0] + st[1]) + (st[2] + st[3])) * (1.0f / 1024.0f) + EPS);
#pragma unroll
                    for (int bj = 0; bj < 2; ++bj) {
                        f32x4 v0 = acc[ai][bj][m][0] * rstd + bv[bj][0], v1 = acc[ai][bj][m][1] * rstd + bv[bj][1];
                        if (u.pn == 5) {
                            int b, key; if (!is_ctx) { b = row >> 13; key = row & (SEQ - 1); } else { const int rc = row - NTOK; b = rc >> 8; key = SEQ + (rc & 255); }
                            const int g = bj * 2 + (wc >> 1), d0 = (wc & 1) * 32 + 8 * fq;
                            h16* vp = Vt + ((size_t)((b * 4 + g) * 64 + d0)) * KVL + key;
#pragma unroll
                            for (int e = 0; e < 4; ++e) { vp[(size_t)e * KVL] = (h16)v0[e]; vp[(size_t)(4 + e) * KVL] = (h16)v1[e]; }
                        } else {
#pragma unroll
                            for (int e = 0; e < 4; ++e) { v0[e] = silu_f(v0[e]); v1[e] = silu_f(v1[e]); }
                            *(u32x4*)(Z + (size_t)row * DM + (u.pn - 6) * 256 + bj * 128 + cw) = pk8(v0, v1);
                        }
                    }
                }
        }
    }
};

__device__ __forceinline__ int attn_srccol(int np);
template <bool ATTN>
__device__ __forceinline__ void tr_plain_item(const float* W, int N, h16* WT, LAS float* scr, int item, int lane) {
    const int nblk = N / 32, kb = item / nblk, nb = item % nblk, k0 = 64 * kb, n0 = 32 * nb;
    const int sc = ATTN ? attn_srccol(n0 + (lane & 31)) : (n0 + (lane & 31));
#pragma unroll 8
    for (int i = 0; i < 32; ++i) { const int kk = 2 * i + (lane >> 5); scr[kk * 33 + (lane & 31)] = W[(size_t)(k0 + kk) * N + sc]; }
    const int c = lane & 7;
#pragma unroll
    for (int j = 0; j < 4; ++j) { const int n = (lane >> 3) + 8 * j; const LAS float* s = scr + (8 * c) * 33 + n;
        u32x4 o; o.x = pk2(s[0 * 33], s[1 * 33]); o.y = pk2(s[2 * 33], s[3 * 33]); o.z = pk2(s[4 * 33], s[5 * 33]); o.w = pk2(s[6 * 33], s[7 * 33]);
        *(u32x4*)(WT + (size_t)(n0 + n) * 1024 + k0 + 8 * c) = o; }
}
__device__ __forceinline__ int attn_srccol(int np) {
    if (np >= 1280) return np;
    const int pn = np >> 8, nn = np & 255, bj = nn >> 7, wc = (nn >> 5) & 3, fq = (nn >> 3) & 3, j = nn & 7;
    return pn * 256 + 64 * wc + 32 * (fq >> 1) + 16 * bj + 8 * (fq & 1) + j;
}
template <int MODE>
__device__ __forceinline__ void gemv9_task(const Params& P, const float* W, int N, int col0, const float* modl, float* out, int ostride, int ocol, const float* addv, int lane) {
    f32x4 a[9];
#pragma unroll
    for (int b = 0; b < 9; ++b) a[b] = (f32x4){0.f, 0.f, 0.f, 0.f};
    for (int j = 0; j < 16; ++j) {
        const int k = lane + 64 * j;
        const f32x4 w = *(const f32x4*)(W + (size_t)k * N + col0);
#pragma unroll
        for (int b = 0; b < 9; ++b) {
            float sv;
            if (MODE == 0) { const float cv = (b < 8) ? P.c[b * DM + k] : P.c_ctx[k]; sv = silu_f(cv); }
            else sv = modl[b * 3072 + k];
            a[b] += w * sv;
        }
    }
#pragma unroll
    for (int b = 0; b < 9; ++b) {
#pragma unroll
        for (int e = 0; e < 4; ++e) a[b][e] = wave_sum(a[b][e]);
    }
    if (lane == 0) {
#pragma unroll
        for (int b = 0; b < 9; ++b) { f32x4 r = a[b]; if (addv) r += *(const f32x4*)(addv + ocol); *(f32x4*)(out + (size_t)b * ostride + ocol) = r; }
    }
}

__device__ __forceinline__ void s5_tables(const Params& P, int g, int qt, LAS unsigned char* lds) {
    LAS f32x2* E = (LAS f32x2*)lds;
    LAS f32x2* Bb = (LAS f32x2*)(lds + 33792);
    LAS f32x2* Cc = (LAS f32x2*)(lds + 50176);
    LAS float* Kt = (LAS float*)(lds + 66816);
    const int tid = threadIdx.x;
    for (int idx = tid; idx < 2 * 64 * 33; idx += 512) {
        const int d = idx / 2112, rem = idx % 2112, p = rem / 33, k = rem % 33;
        const float dt = expf(P.log_dt[d * 64 + g]); const float ar = P.a_re[(d * 64 + g) * 64 + p], ai = P.a_im[(d * 64 + g) * 64 + p];
        const float re = ar * dt * (float)k, im = ai * dt * (float)k; const float mg = expf(re);
        E[idx] = (f32x2){mg * cosf(im), mg * sinf(im)};
    }
    for (int idx = tid; idx < 2048; idx += 512) {
        const int d = idx >> 10, p = (idx >> 4) & 63, h = idx & 15;
        const float dt = expf(P.log_dt[d * 64 + g]); const float ar = P.a_re[(d * 64 + g) * 64 + p], ai = P.a_im[(d * 64 + g) * 64 + p];
        const float zr = ar * dt, zi = ai * dt; const float er = expm1f(zr), cz = cosf(zi), sz = sinf(zi), sh = sinf(0.5f * zi);
        const float nr = er * cz - 2.0f * sh * sh, ni = (er + 1.0f) * sz;
        const float den = 1.0f / (ar * ar + ai * ai); const float qr = (nr * ar + ni * ai) * den, qi = (ni * ar - nr * ai) * den;
        const float br = P.b_re[((size_t)(d * 64 + g) * 64 + p) * 16 + h], bi = P.b_im[((size_t)(d * 64 + g) * 64 + p) * 16 + h];
        Bb[idx] = (f32x2){qr * br - qi * bi, qr * bi + qi * br};
    }
    for (int idx = tid; idx < 2048; idx += 512) {
        const int d = idx >> 10, h = (idx >> 6) & 15, p = idx & 63;
        Cc[(d * 16 + h) * 65 + p] = (f32x2){P.c_re[((size_t)(d * 64 + g) * 16 + h) * 64 + p], P.c_im[((size_t)(d * 64 + g) * 16 + h) * 64 + p]};
    }
    __syncthreads();
    for (int t = tid; t < 1024; t += 512) {
        const int d = t >> 9, k = (t >> 4) & 31, h = t & 15;
        float a[16];
#pragma unroll
        for (int e = 0; e < 16; ++e) a[e] = 0.f;
        for (int p = 0; p < 64; ++p) {
            const f32x2 cc = Cc[(d * 16 + h) * 65 + p], ee = E[(d * 64 + p) * 33 + k];
            const float cr = cc.x * ee.x - cc.y * ee.y, ci = cc.x * ee.y + cc.y * ee.x;
            const LAS f32x4* bp = (const LAS f32x4*)(Bb + (d * 64 + p) * 16);
#pragma unroll
            for (int e = 0; e < 8; ++e) { const f32x4 b2 = bp[e]; a[2 * e] += cr * b2[0] - ci * b2[1]; a[2 * e + 1] += cr * b2[2] - ci * b2[3]; }
        }
        LAS f32x4* kp = (LAS f32x4*)(Kt + ((d * 32 + k) * 16 + h) * 16);
#pragma unroll
        for (int e = 0; e < 4; ++e) kp[e] = (f32x4){a[4 * e], a[4 * e + 1], a[4 * e + 2], a[4 * e + 3]};
    }
    __syncthreads();
    h16* W2 = (h16*)(P.ws + WS_W2S) + (size_t)g * 512 * 768;
    for (int idx = qt * 12288 + tid; idx < (qt + 1) * 12288; idx += 512) {
        const int n = idx / 96, kc = idx % 96, k0 = 8 * kc, s = n >> 4, h = n & 15;
        float v[8];
        if (k0 < 512) {
            const int sp = k0 >> 4, hp0 = k0 & 15;
#pragma unroll
            for (int e = 0; e < 8; ++e) {
                const int hp = hp0 + e; float val;
                if (sp < s) val = Kt[((0 * 32 + (s - sp)) * 16 + h) * 16 + hp];
                else if (sp > s) val = Kt[((1 * 32 + (sp - s)) * 16 + h) * 16 + hp];
                else { val = Kt[((0 * 32) * 16 + h) * 16 + hp] + Kt[((1 * 32) * 16 + h) * 16 + hp]; if (hp == h) val += P.ssm_d[g * 16 + h]; }
                v[e] = val;
            }
        } else {
            const int kk0 = k0 - 512, d = kk0 >> 7, p0 = (kk0 >> 1) & 63; const int ke = d == 0 ? s + 1 : 32 - s;
#pragma unroll
            for (int e = 0; e < 4; ++e) {
                const f32x2 cc = Cc[(d * 16 + h) * 65 + p0 + e], ee = E[(d * 64 + p0 + e) * 33 + ke];
                v[2 * e] = cc.x * ee.x - cc.y * ee.y; v[2 * e + 1] = -(cc.x * ee.y + cc.y * ee.x);
            }
        }
        u32x4 o; o.x = pk2(v[0], v[1]); o.y = pk2(v[2], v[3]); o.z = pk2(v[4], v[5]); o.w = pk2(v[6], v[7]);
        *(u32x4*)(W2 + (size_t)n * 768 + k0) = o;
    }
    h16* W1 = (h16*)(P.ws + WS_W1S) + (size_t)g * 256 * 512;
    for (int idx = qt * 4096 + tid; idx < (qt + 1) * 4096; idx += 512) {
        const int n = idx >> 6, k0 = 8 * (idx & 63), d = n >> 7, p = (n >> 1) & 63, ri = n & 1, sp = k0 >> 4, hp0 = k0 & 15;
        const f32x2 ee = E[(d * 64 + p) * 33 + (d == 0 ? 31 - sp : sp)];
        float v[8];
#pragma unroll
        for (int e = 0; e < 8; ++e) { const f32x2 bb = Bb[(d * 64 + p) * 16 + hp0 + e]; v[e] = ri == 0 ? (ee.x * bb.x - ee.y * bb.y) : (ee.x * bb.y + ee.y * bb.x); }
        u32x4 o; o.x = pk2(v[0], v[1]); o.y = pk2(v[2], v[3]); o.z = pk2(v[4], v[5]); o.w = pk2(v[6], v[7]);
        *(u32x4*)(W1 + (size_t)n * 512 + k0) = o;
    }
    __syncthreads();
}

__device__ __forceinline__ void norm_row_h16(const float* xrow, const float* gvec, const float* modrow, h16* orow, int lane) {
    const f32x4* xr = (const f32x4*)xrow + lane; f32x4 v[4]; float s = 0.f;
#pragma unroll
    for (int j = 0; j < 4; ++j) { v[j] = xr[64 * j]; s += (v[j][0] * v[j][0] + v[j][1] * v[j][1]) + (v[j][2] * v[j][2] + v[j][3] * v[j][3]); }
    const float rstd = 1.0f / sqrtf(wave_sum(s) * (1.0f / DM) + EPS);
    u32x2* o8 = (u32x2*)orow + lane;
#pragma unroll
    for (int j = 0; j < 4; ++j) { const f32x4 gg = ((const f32x4*)gvec)[lane + 64 * j], sc = ((const f32x4*)(modrow + 1024))[lane + 64 * j], sh = ((const f32x4*)modrow)[lane + 64 * j];
        const f32x4 w = v[j] * rstd * gg * (sc + 1.0f) + sh; u32x2 o; o.x = pk2(w[0], w[1]); o.y = pk2(w[2], w[3]); o8[64 * j] = o; }
}

__device__ __forceinline__ void scan_phase(const Params& P) {
    const int gid = blockIdx.x * 512 + threadIdx.x;
    const int nthr = gridDim.x * 512;
    const float* __restrict__ S = (const float*)(P.ws + WS_X1);
    h16* __restrict__ UH = (h16*)(P.ws + WS_UH);
    for (int id = gid; id < NB * 64 * 2 * 64; id += nthr) {
        const int p = id & 63, d = (id >> 6) & 1, g = (id >> 7) & 63, b = id >> 13;
        const float dt = expf(P.log_dt[d * 64 + g]); const float ar = P.a_re[(d * 64 + g) * 64 + p], ai = P.a_im[(d * 64 + g) * 64 + p];
        const float mg = expf(ar * dt * (float)TCH), an = ai * dt * (float)TCH; const float tr = mg * cosf(an), ti = mg * sinf(an);
        float hr = 0.f, hi = 0.f;
        const size_t colS = (size_t)d * 128 + 2 * p, colH = 512 + (size_t)d * 128 + 2 * p;
        for (int q = 0; q < 8; ++q) {
            const int cc = d == 0 ? q : 7 - q; const size_t row = (size_t)g * NCHP + 2048 + b * 8 + cc;
            const f32x2 sv = *(const f32x2*)(S + row * 256 + colS);
            *(unsigned*)(UH + row * UHW + colH) = pk2(hr, hi);
            const float nr = tr * hr - ti * hi + sv.x, ni = tr * hi + ti * hr + sv.y; hr = nr; hi = ni;
        }
        for (int q0 = 0; q0 < 256; q0 += 8) {
            f32x2 sv[8];
#pragma unroll
            for (int e = 0; e < 8; ++e) { const int cq = d == 0 ? q0 + e : 255 - q0 - e; sv[e] = *(const f32x2*)(S + ((size_t)g * NCHP + b * 256 + cq) * 256 + colS); }
#pragma unroll
            for (int e = 0; e < 8; ++e) {
                const int cq = d == 0 ? q0 + e : 255 - q0 - e; const size_t row = (size_t)g * NCHP + b * 256 + cq;
                *(unsigned*)(UH + row * UHW + colH) = pk2(hr, hi);
                const float nr = tr * hr - ti * hi + sv[e].x, ni = tr * hi + ti * hr + sv[e].y; hr = nr; hi = ni;
            }
        }
    }
}

__device__ __forceinline__ int attn_crow(int r, int hi) { return (r & 3) + 8 * (r >> 2) + 4 * hi; }
template <bool ADDC>
__device__ __forceinline__ void attn_units(const Params& P, LAS unsigned char* lds, const float cadd) {
    int tid = threadIdx.x; asm volatile("" : "+v"(tid));
    const int lane = tid & 63, wid = __builtin_amdgcn_readfirstlane(tid >> 6), r32 = lane & 31, hi = lane >> 5;
    const h16* Q = (const h16*)(P.ws + WS_UH); const h16* Kb = (const h16*)(P.ws + WS_K); const h16* Vt = (const h16*)(P.ws + WS_VT);
    const h16* Z = (const h16*)(P.ws + WS_BUFZ); h16* OG = (h16*)(P.ws + WS_BUFA);
    LAS float* lsc = (LAS float*)(lds + 131072) + wid * 64;
    const int drow = 8 * wid + (lane >> 3), dchk = (lane & 7) ^ ((drow >> 1) & 7);
    const unsigned kdoff = (unsigned)(drow * 128 + dchk * 16), vdoff = (unsigned)((drow * KVL + dchk * 8) * 2);
    int kro[2], krx[2], vro[2], vrx[2];
#pragma unroll
    for (int kh = 0; kh < 2; ++kh) {
        const int i = r32 & 15; const int pr = (r32 & 16) | (i & 3) | ((i & 4) << 1) | ((i & 8) >> 1);
        const int row = 32 * kh + pr; kro[kh] = row * 128; krx[kh] = (row >> 1) & 7;
        const int dr = 32 * kh + r32; vro[kh] = dr * 128; vrx[kh] = (dr >> 1) & 7;
    }
    const f32x16 zero16 = {0.f, 0.f, 0.f, 0.f, 0.f, 0.f, 0.f, 0.f, 0.f, 0.f, 0.f, 0.f, 0.f, 0.f, 0.f, 0.f};
    for (int u = blockIdx.x; u < 2048; u += gridDim.x) {
        const int xx = u & 7, jj = u >> 3, bg = xx + 8 * (jj >> 6), qblk = jj & 63;
        const int b = bg >> 2, g = bg & 3, hh = 4 * g + (wid & 3), tok = qblk * 128 + (wid >> 2) * 64;
        h16x8 qr[2][4];
#pragma unroll
        for (int rb = 0; rb < 2; ++rb) { const h16* qp = Q + ((size_t)(b * SEQ + tok + 32 * rb + r32)) * DM + hh * 64 + hi * 8;
#pragma unroll
            for (int d0 = 0; d0 < 4; ++d0) qr[rb][d0] = *(const h16x8*)(qp + 16 * d0); }
        const char* kbase = (const char*)(Kb + (size_t)bg * KVL * 64);
        const char* vbase = (const char*)(Vt + (size_t)bg * 64 * KVL);
        f32x16 o00 = zero16, o01 = zero16, o10 = zero16, o11 = zero16;
        float lsum0 = 0.f, lsum1 = 0.f;
#define ATT_DMA(sg_, slot_) do { const int t0_ = 4 * (sg_); LAS unsigned char* d_ = lds + (slot_) * 65536 + wid * 1024; \
        _Pragma("unroll 1") for (int q_ = 0; q_ < 4; ++q_) { \
            __builtin_amdgcn_global_load_lds((const unsigned*)(kbase + (size_t)(t0_ + q_) * 8192 + kdoff), (LAS unsigned*)(d_ + q_ * 8192), 16, 0, 0); \
            __builtin_amdgcn_global_load_lds((const unsigned*)(vbase + (size_t)(t0_ + q_) * 128 + vdoff), (LAS unsigned*)(d_ + 32768 + q_ * 8192), 16, 0, 0); } } while (0)
        ATT_DMA(0, 0);
#pragma unroll
        for (int rb = 0; rb < 2; ++rb)
#pragma unroll
            for (int d0 = 0; d0 < 4; ++d0) asm volatile("" :: "v"(qr[rb][d0]));
        asm volatile("s_waitcnt vmcnt(0)" ::: "memory"); __builtin_amdgcn_s_barrier(); asm volatile("" ::: "memory");
        for (int sg = 0; sg < 33; ++sg) {
            const int slot = sg & 1;
            if (wid & 4) __builtin_amdgcn_s_sleep(12);
            if (sg + 1 < 33) ATT_DMA(sg + 1, slot ^ 1);
#pragma unroll 1
            for (int j = 0; j < 4; ++j) {
                const LAS unsigned char* kb = lds + slot * 65536 + j * 8192; const LAS unsigned char* vb = kb + 32768;
                f32x16 s00, s01, s10, s11;
#pragma unroll
                for (int d0 = 0; d0 < 4; ++d0) {
                    const h16x8 a0 = *(const LAS h16x8*)(kb + kro[0] + (((2 * d0 + hi) ^ krx[0]) << 4));
                    const h16x8 a1 = *(const LAS h16x8*)(kb + kro[1] + (((2 * d0 + hi) ^ krx[1]) << 4));
                    s00 = __builtin_amdgcn_mfma_f32_32x32x16_f16(a0, qr[0][d0], d0 == 0 ? zero16 : s00, 0, 0, 0);
                    s10 = __builtin_amdgcn_mfma_f32_32x32x16_f16(a0, qr[1][d0], d0 == 0 ? zero16 : s10, 0, 0, 0);
                    s01 = __builtin_amdgcn_mfma_f32_32x32x16_f16(a1, qr[0][d0], d0 == 0 ? zero16 : s01, 0, 0, 0);
                    s11 = __builtin_amdgcn_mfma_f32_32x32x16_f16(a1, qr[1][d0], d0 == 0 ? zero16 : s11, 0, 0, 0);
                }
#pragma unroll
                for (int ks = 0; ks < 4; ++ks) {
                    float p0[8], p1[8];
#pragma unroll
                    for (int e = 0; e < 8; ++e) {
                        float v0 = ks < 2 ? s00[8 * (ks & 1) + e] : s01[8 * (ks & 1) + e];
                        float v1 = ks < 2 ? s10[8 * (ks & 1) + e] : s11[8 * (ks & 1) + e];
                        if (ADDC) { v0 += cadd; v1 += cadd; }
                        p0[e] = __builtin_amdgcn_exp2f(v0); p1[e] = __builtin_amdgcn_exp2f(v1);
                    }
                    lsum0 += ((p0[0] + p0[1]) + (p0[2] + p0[3])) + ((p0[4] + p0[5]) + (p0[6] + p0[7]));
                    lsum1 += ((p1[0] + p1[1]) + (p1[2] + p1[3])) + ((p1[4] + p1[5]) + (p1[6] + p1[7]));
                    u32x4 w0, w1;
                    w0.x = pk2(p0[0], p0[1]); w0.y = pk2(p0[2], p0[3]); w0.z = pk2(p0[4], p0[5]); w0.w = pk2(p0[6], p0[7]);
                    w1.x = pk2(p1[0], p1[1]); w1.y = pk2(p1[2], p1[3]); w1.z = pk2(p1[4], p1[5]); w1.w = pk2(p1[6], p1[7]);
                    const h16x8 pa0 = __builtin_bit_cast(h16x8, w0), pa1 = __builtin_bit_cast(h16x8, w1);
                    const h16x8 b0 = *(const LAS h16x8*)(vb + vro[0] + (((2 * ks + hi) ^ vrx[0]) << 4));
                    const h16x8 b1 = *(const LAS h16x8*)(vb + vro[1] + (((2 * ks + hi) ^ vrx[1]) << 4));
                    o00 = __builtin_amdgcn_mfma_f32_32x32x16_f16(pa0, b0, o00, 0, 0, 0);
                    o10 = __builtin_amdgcn_mfma_f32_32x32x16_f16(pa1, b0, o10, 0, 0, 0);
                    o01 = __builtin_amdgcn_mfma_f32_32x32x16_f16(pa0, b1, o01, 0, 0, 0);
                    o11 = __builtin_amdgcn_mfma_f32_32x32x16_f16(pa1, b1, o11, 0, 0, 0);
                }
            }
            asm volatile("s_waitcnt vmcnt(0) lgkmcnt(0)" ::: "memory"); __builtin_amdgcn_s_barrier(); asm volatile("" ::: "memory");
        }
        lsum0 += __shfl_xor(lsum0, 32); lsum1 += __shfl_xor(lsum1, 32);
        if (hi == 0) { lsc[r32] = lsum0; lsc[32 + r32] = lsum1; }
        __builtin_amdgcn_s_waitcnt(0xc07f);
        asm volatile("" ::: "memory");
#pragma unroll
        for (int r = 0; r < 16; ++r) {
            const int q = attn_crow(r, hi); const float li0 = 1.0f / lsc[q], li1 = 1.0f / lsc[32 + q];
            const size_t off0 = ((size_t)(b * SEQ + tok + q)) * DM + hh * 64 + r32, off1 = off0 + (size_t)32 * DM;
            OG[off0] = (h16)(o00[r] * li0 * (float)Z[off0]); OG[off0 + 32] = (h16)(o01[r] * li0 * (float)Z[off0 + 32]);
            OG[off1] = (h16)(o10[r] * li1 * (float)Z[off1]); OG[off1 + 32] = (h16)(o11[r] * li1 * (float)Z[off1 + 32]);
        }
    }
}
__device__ __forceinline__ void attn_phase(const Params& P, LAS unsigned char* lds) {
    const int lane = threadIdx.x & 63;
    const float mq = wave_max(fabsf(P.q_norm[lane])), mk = wave_max(fabsf(P.k_norm[lane]));
    const float M = 8.0f * mq * mk;
    if (M <= 10.5f) attn_units<false>(P, lds, 0.f);
    else attn_units<true>(P, lds, -((M - 10.5f) * LOG2E));
}

constexpr size_t WS_BAR = 640 * 1024;
#define XB_TMO      128
#define XB_XCNT(j)  (256  + 64 * (j))
#define XB_XSUB(j)  (1280 + 64 * (j))
#define XB_XGEN(j)  (2304 + 64 * (j))
#define XB_TOP      3328
#define XB_TOPGEN   3392
#define XCD_BAR_WORDS 3456
#define XB_SPIN_CAP (1u << 18)
__device__ __forceinline__ unsigned xb_ld(unsigned* p)              { return __hip_atomic_load(p, __ATOMIC_RELAXED, __HIP_MEMORY_SCOPE_AGENT); }
__device__ __forceinline__ unsigned xb_add(unsigned* p, unsigned v) { return __hip_atomic_fetch_add(p, v, __ATOMIC_RELAXED, __HIP_MEMORY_SCOPE_AGENT); }
__device__ __forceinline__ unsigned xb_xcc_id() { return (unsigned)__builtin_amdgcn_s_getreg((3 << 11) | 20) & 0xFu; }
#define XB_SPIN(cond, bar) do { unsigned _sp = 0; while (cond) { __builtin_amdgcn_s_sleep(1); \
    if ((++_sp & 255u) == 0u) { if (xb_ld(&(bar)[XB_TMO])) break; if (_sp > XB_SPIN_CAP) { atomicAdd(&(bar)[XB_TMO], 1u); break; } } } } while (0)
struct XcdBarrier { unsigned* bar; unsigned x; volatile LAS unsigned* st; };
__device__ __forceinline__ XcdBarrier xcd_barrier_post(unsigned* bar, volatile LAS unsigned* st) {
    XcdBarrier b; b.bar = bar; b.x = xb_xcc_id(); b.st = st;
    if (threadIdx.x == 0) (void)xb_add(&bar[XB_XCNT(b.x)], 1u);
    return b;
}
__device__ __forceinline__ void xcd_barrier_complete(unsigned* bar, unsigned x, unsigned& nloc, unsigned& nx) {
    const unsigned G = gridDim.x * gridDim.y * gridDim.z;
    unsigned sum, cnt, mine, sp = 0u;
    for (;;) {
        sum = 0u; cnt = 0u; mine = 0u;
#pragma unroll
        for (unsigned j = 0; j < 16; ++j) { const unsigned c = xb_ld(&bar[XB_XCNT(j)]); sum += c; cnt += (c > 0u) ? 1u : 0u; mine = (j == x) ? c : mine; }
        if (sum == G) break;
        __builtin_amdgcn_s_sleep(1);
        if ((++sp & 255u) == 0u) { if (xb_ld(&bar[XB_TMO])) break; if (sp > XB_SPIN_CAP) { atomicAdd(&bar[XB_TMO], 1u); break; } }
    }
    nloc = mine > 0u ? mine : 1u; nx = cnt > 0u ? cnt : 1u;
}
__device__ __forceinline__ void xcd_barrier(const XcdBarrier& b) {
    asm volatile("s_waitcnt vmcnt(0)" ::: "memory");
    __syncthreads();
    if (threadIdx.x == 0) {
        unsigned* bar = b.bar;
        __builtin_amdgcn_s_waitcnt(0);
        unsigned nloc = b.st[0], nx = b.st[1];
        if (nloc == 0u) { xcd_barrier_complete(bar, b.x, nloc, nx); b.st[0] = nloc; b.st[1] = nx; }
        const unsigned old = xb_add(&bar[XB_XSUB(b.x)], 1u);
        const unsigned gen = old / nloc;
        if (old + 1u == (gen + 1u) * nloc) {
            __builtin_amdgcn_fence(__ATOMIC_RELEASE, "agent");
            asm volatile("s_waitcnt vmcnt(0)" ::: "memory");
            const unsigned og = xb_add(&bar[XB_TOP], 1u);
            const unsigned tg = og / nx;
            if (og + 1u == (tg + 1u) * nx) xb_add(&bar[XB_TOPGEN], 1u);
            else XB_SPIN(xb_ld(&bar[XB_TOPGEN]) == tg, bar);
            __builtin_amdgcn_fence(__ATOMIC_ACQUIRE, "agent");
            xb_add(&bar[XB_XGEN(b.x)], 1u);
            asm volatile("s_waitcnt vmcnt(0)" ::: "memory");
        } else {
            XB_SPIN(xb_ld(&bar[XB_XGEN(b.x)]) == gen, bar);
            __builtin_amdgcn_fence(__ATOMIC_ACQUIRE, "agent");
            asm volatile("s_waitcnt vmcnt(0)" ::: "memory");
        }
    }
    __syncthreads();
}

__global__ void __launch_bounds__(512) fwd_megakernel(Params P) {
    extern __shared__ __attribute__((aligned(16))) unsigned char lds_raw[];
    LAS unsigned char* lds = (LAS unsigned char*)lds_raw;
    cg::grid_group grid = cg::this_grid();
    const int G = gridDim.x, bx = blockIdx.x;
    unsigned char* ws = P.ws;
    float* MOD = (float*)(ws + WS_MOD);
#define THREAD_IDS int tid = threadIdx.x; asm volatile("" : "+v"(tid)); const int lane = tid & 63, wave = __builtin_amdgcn_readfirstlane(tid >> 6); const int gw = bx * 8 + wave, NGW = G * 8; LAS float* scr = (LAS float*)(lds + wave * 16384); (void)scr; (void)lane; (void)gw; (void)NGW; (void)tid;

    volatile LAS unsigned* bst = (volatile LAS unsigned*)(lds + LDS_BYTES - 64);
    if (threadIdx.x == 0) { bst[0] = 0u; bst[1] = 0u; }
    if (bx == 0) for (int i = threadIdx.x; i < XCD_BAR_WORDS; i += 512) ((unsigned*)(ws + WS_BAR))[i] = 0u;
    for (int t = bx; t < 256; t += G) s5_tables(P, t >> 2, t & 3, lds);
    {   THREAD_IDS
        if (bx == G - 1) for (int idx = tid; idx < 2048; idx += 512) {
            const int pos = idx >> 4, i = idx & 15; const float fr = powf(10000.0f, -(float)i / 16.0f); const float an = (float)pos * fr;
            ((float*)(ws + WS_ROPEC))[idx] = cosf(an); ((float*)(ws + WS_ROPES))[idx] = sinf(an);
        }
        for (int t = gw; t < 2 * 768; t += NGW) { const int l = t / 768, n4 = t % 768;
            gemv9_task<0>(P, P.w_mod + (size_t)l * DM * 3072, 3072, 4 * n4, nullptr, MOD + l * 9 * 3072, 3072, 4 * n4, P.b_mod + l * 3072, lane); }
        for (int it = gw; it < 1024 + 1280 + 3 * 512; it += NGW) {
            if (it < 1024) tr_plain_item<false>(P.ssm_w_in, 2048, (h16*)(ws + WS_WB0), scr, it, lane);
            else if (it < 2304) tr_plain_item<true>(P.attn_w_in, 2560, (h16*)(ws + WS_WB1), scr, it - 1024, lane);
            else { const int w = (it - 2304) / 512, r = (it - 2304) % 512;
                const float* src = w == 0 ? P.w_glu : (w == 1 ? P.ssm_w_out : P.attn_w_out); h16* dst = (h16*)(ws + (w == 0 ? WS_WGLU : (w == 1 ? WS_WOUT0 : WS_WOUT1)));
                tr_plain_item<false>(src, 1024, dst, scr, r, lane); }
        }
    }
    grid.sync();
    (void)xcd_barrier_post((unsigned*)(ws + WS_BAR), bst);
#define GRID_BAR() do { XcdBarrier xb_; xb_.bar = (unsigned*)(P.ws + WS_BAR); xb_.x = xb_xcc_id(); xb_.st = (volatile LAS unsigned*)(lds + LDS_BYTES - 64); xcd_barrier(xb_); } while (0)
    {   THREAD_IDS
        h16* XN = (h16*)(ws + WS_BUFA);
        for (int m = gw; m < MTOT; m += NGW) { const float* xr = m < NTOK ? P.x + (size_t)m * DM : P.ctx + (size_t)(m - NTOK) * DM;
            norm_row_h16(xr, P.norm_g, MOD + (m < NTOK ? (m >> 13) : 8) * 3072, XN + (size_t)m * DM, lane); }
        for (int t = gw; t < 640; t += NGW) { const int np = 4 * t; gemv9_task<1>(P, P.attn_w_in, 2560, attn_srccol(np), MOD + 9 * 3072, (float*)(ws + WS_BIAS1), 2560, np, nullptr, lane); }
        for (int i = bx * 512 + tid; i < 9 * 1024; i += G * 512) { const int bs = i >> 10, k = i & 1023; ((float*)(ws + WS_BIAS0))[i] = P.norm_g[DM + k] * (1.0f + MOD[9 * 3072 + bs * 3072 + 1024 + k]); }
    }
    GRID_BAR();
    {
        pg8::Gemm g{(const h16*)(ws + WS_BUFA), (const h16*)(ws + WS_WB0), 1024, 1024, 1024};
        pg8::SchedPlain S; S.init(MTOT, 2048, G, bx, 1024, 1024, 0);
        EpiSsmIn E{(h16*)(ws + WS_UH), (h16*)(ws + WS_BUFZ)};
        pg8::gemm_phase(lds, g, S, E);
    }
    GRID_BAR();
    {
        pg8::Gemm g{(const h16*)(ws + WS_UH), (const h16*)(ws + WS_W1S), UHW, 512, 512};
        pg8::SchedGrouped S; S.init(NCHP, 256, 64, G, bx, UHW, 512, (size_t)NCHP * UHW, (size_t)256 * 512);
        EpiS5State E{(float*)(ws + WS_X1)};
        pg8::gemm_phase(lds, g, S, E);
    }
    GRID_BAR();
    scan_phase(P);
    GRID_BAR();
    {
        pg8::Gemm g{(const h16*)(ws + WS_UH), (const h16*)(ws + WS_W2S), UHW, 768, 768};
        pg8::SchedGrouped S; S.init(NCHP, 512, 64, G, bx, UHW, 768, (size_t)NCHP * UHW, (size_t)512 * 768);
        EpiS5Out E{(h16*)(ws + WS_BUFA)};
        pg8::gemm_phase(lds, g, S, E);
    }
    GRID_BAR();
    {
        pg8::Gemm g{(const h16*)(ws + WS_BUFA), (const h16*)(ws + WS_WGLU), 1024, 1024, 1024};
        pg8::SchedPlain S; S.init(MTOT, 1024, G, bx, 1024, 1024, 0);
        EpiGlu E{(const h16*)(ws + WS_BUFA), (const h16*)(ws + WS_BUFZ), P.b_glu, (h16*)(ws + WS_UH)};
        pg8::gemm_phase(lds, g, S, E);
    }
    GRID_BAR();
    {
        pg8::Gemm g{(const h16*)(ws + WS_UH), (const h16*)(ws + WS_WOUT0), 1024, 1024, 1024};
        pg8::SchedPlain S; S.init(MTOT, 1024, G, bx, 1024, 1024, 0);
        EpiOut<false> E{P.x, P.ctx, nullptr, MOD + 2048, (h16*)(ws + WS_X1), (h16*)(ws + WS_BUFA), (const float*)(ws + WS_BIAS0), (float*)(ws + WS_SSQ1)};
        pg8::gemm_phase(lds, g, S, E);
    }
    GRID_BAR();
    {
        pg8::Gemm g{(const h16*)(ws + WS_BUFA), (const h16*)(ws + WS_WB1), 1024, 1024, 1024};
        pg8::SchedPlain S; S.init(MTOT, 2560, G, bx, 1024, 1024, 0);
        EpiAttnIn E{(const float*)(ws + WS_SSQ1), (const float*)(ws + WS_BIAS1), P.q_norm, P.k_norm, (const float*)(ws + WS_ROPEC), (const float*)(ws + WS_ROPES),
                    (h16*)(ws + WS_UH), (h16*)(ws + WS_K), (h16*)(ws + WS_VT), (h16*)(ws + WS_BUFZ)};
        pg8::gemm_phase(lds, g, S, E);
    }
    GRID_BAR();
    attn_phase(P, lds);
    GRID_BAR();
    {
        pg8::Gemm g{(const h16*)(ws + WS_BUFA), (const h16*)(ws + WS_WOUT1), 1024, 1024, 1024};
        pg8::SchedPlain S; S.init(NTOK, 1024, G, bx, 1024, 1024, 0);
        EpiOut<true> E{nullptr, nullptr, (const h16*)(ws + WS_X1), MOD + 9 * 3072 + 2048, (h16*)(ws + WS_UH), nullptr, nullptr, (float*)(ws + WS_SSQ2)};
        pg8::gemm_phase(lds, g, S, E);
    }
    GRID_BAR();
    {   THREAD_IDS
        const float* __restrict__ ssq = (const float*)(ws + WS_SSQ2);
        const h16* __restrict__ X2 = (const h16*)(ws + WS_UH);
        float* __restrict__ outp = P.out;
        f32x4 gg[4];
#pragma unroll
        for (int j = 0; j < 4; ++j) gg[j] = ((const f32x4*)P.final_g)[lane + 64 * j];
        for (int m = gw; m < NTOK; m += NGW) {
            const f32x4 s0 = *(const f32x4*)(ssq + (size_t)m * 16), s1 = *(const f32x4*)(ssq + (size_t)m * 16 + 4), s2 = *(const f32x4*)(ssq + (size_t)m * 16 + 8), s3 = *(const f32x4*)(ssq + (size_t)m * 16 + 12);
            const h16x4* xi = (const h16x4*)(X2 + (size_t)m * DM) + lane;
            f32x4 v[4];
#pragma unroll
            for (int j = 0; j < 4; ++j) { const h16x4 w = xi[64 * j]; v[j] = (f32x4){(float)w[0], (float)w[1], (float)w[2], (float)w[3]}; }
            const f32x4 st = (s0 + s1) + (s2 + s3);
            const float rstd = 1.0f / sqrtf(((st[0] + st[1]) + (st[2] + st[3])) * (1.0f / DM) + EPS);
            f32x4* o = (f32x4*)(outp + (size_t)m * DM) + lane;
#pragma unroll
            for (int j = 0; j < 4; ++j) o[64 * j] = v[j] * rstd * gg[j];
        }
    }
}

extern "C" void kernel_launch(void* const* d_in, const int* in_sizes, int n_in, void* d_out, int out_size, void* d_ws, size_t ws_size, hipStream_t stream) {
    static int grid_blocks = 0;
    if (grid_blocks == 0) {
        if (n_in != 24 || ws_size < WS_END) { fprintf(stderr, "kernel_launch: unexpected inputs (n_in %d, ws %zu)\n", n_in, ws_size); grid_blocks = -1; return; }
        int dev = 0, cus = 0, per_cu = 0;
        hipGetDevice(&dev);
        hipDeviceGetAttribute(&cus, hipDeviceAttributeMultiprocessorCount, dev);
        hipFuncSetAttribute((const void*)fwd_megakernel, hipFuncAttributeMaxDynamicSharedMemorySize, LDS_BYTES);
        hipOccupancyMaxActiveBlocksPerMultiprocessor(&per_cu, (const void*)fwd_megakernel, 512, LDS_BYTES);
        if (per_cu < 1) per_cu = 1;
        grid_blocks = cus * per_cu;
        (void)hipGetLastError();
    }
    if (grid_blocks < 0) return;
    Params p{};
    const float** pp = (const float**)&p;
    for (int i = 0; i < 24; ++i) pp[i] = (const float*)d_in[i];
    p.out = (float*)d_out; p.ws = (unsigned char*)d_ws;
    void* args[] = {&p};
    hipError_t e = hipLaunchCooperativeKernel((const void*)fwd_megakernel, dim3(grid_blocks), dim3(512), args, LDS_BYTES, stream);
    if (e != hipSuccess) fprintf(stderr, "cooperative launch failed: %s (grid %d)\n", hipGetErrorString(e), grid_blocks);
}
```

```cpp
#include <hip/hip_runtime.h>
#include <hip/hip_cooperative_groups.h>
#include <cstdio>
#include <cstdint>
namespace cg = cooperative_groups;

#define LAS __attribute__((address_space(3)))
typedef _Float16 h16;
typedef _Float16 h16x8 __attribute__((ext_vector_type(8)));
typedef _Float16 h16x2 __attribute__((ext_vector_type(2)));
typedef _Float16 h16x4 __attribute__((ext_vector_type(4)));
typedef float f32x4 __attribute__((ext_vector_type(4)));
typedef float f32x2 __attribute__((ext_vector_type(2)));
typedef float f32x16 __attribute__((ext_vector_type(16)));
typedef unsigned u32x4 __attribute__((ext_vector_type(4)));
typedef unsigned u32x2 __attribute__((ext_vector_type(2)));

constexpr int DM = 1024, NB = 8, SEQ = 8192, CTXL = 256;
constexpr int NTOK = NB * SEQ;
constexpr int NCTX = NB * CTXL;
constexpr int MTOT = NTOK + NCTX;
constexpr int TCH = 32;
constexpr int NCH = MTOT / TCH;
constexpr int NCHP = 2304;
constexpr int UHW = 768;
constexpr int KVL = SEQ + CTXL;
constexpr int NKT = KVL / 64;
constexpr float EPS = 1e-6f;
constexpr float LOG2E = 1.4426950408889634f;
constexpr float QSCALE = 0.125f * LOG2E;

constexpr size_t MiB = 1u << 20;
constexpr size_t WS_MOD = 0;
constexpr size_t WS_BIAS0 = 1 * MiB;
constexpr size_t WS_BIAS1 = 1 * MiB + 512 * 1024;
constexpr size_t WS_ROPEC = 2 * MiB;
constexpr size_t WS_ROPES = 3 * MiB;
constexpr size_t WS_SSQ1 = 4 * MiB;
constexpr size_t WS_SSQ2 = 9 * MiB;
constexpr size_t WS_WGLU = 16 * MiB;
constexpr size_t WS_WOUT0 = 18 * MiB;
constexpr size_t WS_WOUT1 = 20 * MiB;
constexpr size_t WS_W1S = 22 * MiB;
constexpr size_t WS_W2S = 38 * MiB;
constexpr size_t WS_WB0 = 86 * MiB;
constexpr size_t WS_WB1 = 122 * MiB;
constexpr size_t WS_K = 168 * MiB;
constexpr size_t WS_VT = 202 * MiB;
constexpr size_t WS_BUFA = 236 * MiB;
constexpr size_t WS_BUFZ = 368 * MiB;
constexpr size_t WS_UH = 500 * MiB;
constexpr size_t WS_X1 = 716 * MiB;
constexpr size_t WS_END = 980 * MiB;
static_assert(WS_W2S + (size_t)64 * 512 * 768 * 2 <= WS_WB0 && WS_WB0 + (size_t)9 * 2048 * 1024 * 2 <= WS_WB1 && WS_WB1 + (size_t)9 * 2560 * 1024 * 2 <= WS_K, "ws map 1");
static_assert(WS_K + (size_t)32 * KVL * 64 * 2 <= WS_VT && WS_VT + (size_t)32 * KVL * 64 * 2 <= WS_BUFA && WS_BUFA + (size_t)MTOT * DM * 2 <= WS_BUFZ, "ws map 2");
static_assert(WS_BUFZ + (size_t)MTOT * DM * 2 <= WS_UH && WS_UH + (size_t)64 * NCHP * UHW * 2 <= WS_X1 && WS_X1 + (size_t)MTOT * DM * 4 <= WS_END, "ws map 3");
static_assert((size_t)64 * NCHP * 256 * 4 <= (size_t)MTOT * DM * 4, "S fits in X1 region");

constexpr int LDS_BYTES = 147456;

struct Params {
    const float *x, *c, *ctx, *c_ctx, *w_mod, *b_mod, *norm_g, *ssm_w_in, *a_re, *a_im, *log_dt, *b_re, *b_im, *c_re, *c_im, *ssm_d,
        *w_glu, *b_glu, *ssm_w_out, *attn_w_in, *q_norm, *k_norm, *attn_w_out, *final_g;
    float* out;
    unsigned char* ws;
};

__device__ __forceinline__ unsigned pk2(float lo, float hi) { f32x2 v = {lo, hi}; h16x2 h = __builtin_convertvector(v, h16x2); return __builtin_bit_cast(unsigned, h); }
__device__ __forceinline__ u32x4 pk8(f32x4 a, f32x4 b) { u32x4 w; w.x = pk2(a[0], a[1]); w.y = pk2(a[2], a[3]); w.z = pk2(b[0], b[1]); w.w = pk2(b[2], b[3]); return w; }
__device__ __forceinline__ float silu_f(float v) { return v * __builtin_amdgcn_rcpf(1.0f + __expf(-v)); }
__device__ __forceinline__ float sigm_f(float v) { return __builtin_amdgcn_rcpf(1.0f + __expf(-v)); }
__device__ __forceinline__ float wave_sum(float v) {
#pragma unroll
    for (int o = 1; o < 64; o <<= 1) v += __shfl_xor(v, o);
    return v;
}
__device__ __forceinline__ float wave_max(float v) {
#pragma unroll
    for (int o = 1; o < 64; o <<= 1) v = fmaxf(v, __shfl_xor(v, o));
    return v;
}
__device__ __forceinline__ void unpack8(const h16* p, float* f) {
    const h16x8 v = *(const h16x8*)p;
#pragma unroll
    for (int i = 0; i < 8; ++i) f[i] = (float)v[i];
}
__device__ __forceinline__ f32x2 gelu_pk(f32x2 v) {
    const f32x2 av = __builtin_elementwise_abs(v), d = av * 0.2316418882f + 1.0f;
    f32x2 t; t.x = __builtin_amdgcn_rcpf(d.x); t.y = __builtin_amdgcn_rcpf(d.y);
    f32x2 q = t * 0.5307027145f + (-0.7265760135f); q = q * t + 0.7107068705f; q = q * t + (-0.142248368f); q = q * t + 0.127414796f; q = q * t;
    const f32x2 s = (v * v) * (-0.72134752044f);
    f32x2 e; e.x = __builtin_amdgcn_exp2f(s.x); e.y = __builtin_amdgcn_exp2f(s.y);
    const f32x2 m = v * (q * e), r = v - m;
    f32x2 o; o.x = v.x < 0.f ? m.x : r.x; o.y = v.y < 0.f ? m.y : r.y; return o;
}
__device__ __forceinline__ int bsel_of_pm(int pm) { return pm < 256 ? (pm >> 5) : 8; }

namespace pg8 {
constexpr int BM = 256, BK = 64, HALF = 128, HTB = HALF * BK * 2, STAGE_BYTES = 8 * HTB, NXCD = 8, WGM = 8;
__device__ __forceinline__ int lds_byte(int r, int c) { const int st = (r >> 4) * 2 + (c >> 5), rr = r & 15, cc = c & 31, ob = rr * 64 + cc * 2; return st * 1024 + (ob ^ (((ob >> 9) & 1) << 5)); }
__device__ __forceinline__ void stage_rc(int b, int& R, int& C) { const int st = b / 1024, sb = b % 1024, swz = sb ^ (((sb >> 9) & 1) << 5); R = (st >> 1) * 16 + swz / 64; C = (st & 1) * 32 + (swz % 64) / 2; }
__device__ __forceinline__ int perm32(int rho) { const int n = rho >> 4, i = rho & 15; return 8 * (i >> 2) + 4 * n + (i & 3); }

struct Unit { int pm, pn, z; };
struct Gemm { const h16* A; const h16* Bt; int lda, ldb, K; };

struct SchedPlain {
    int nM, nN, nwg, G, c, lda, ldb; size_t bsel_stride;
    __device__ void init(int M, int N, int G_, int c_, int lda_, int ldb_, size_t bs) { nM = M / BM; nN = N / BM; nwg = nM * nN; G = G_; c = c_; lda = lda_; ldb = ldb_; bsel_stride = bs; }
    __device__ __forceinline__ bool next(int i, Unit& u) const {
        const long L = (long)i * G + c; if (L >= nwg) return false;
        int wgid = (int)L; { const int q = nwg / NXCD, r = nwg % NXCD, xcd = wgid % NXCD, off = wgid / NXCD; wgid = (xcd < r ? xcd * (q + 1) : r * (q + 1) + (xcd - r) * q) + off; }
        const int nig = WGM * nN, gid = wgid / nig, fm = gid * WGM, gsz = (nM - fm) < WGM ? (nM - fm) : WGM;
        u.pm = fm + ((wgid % nig) % gsz); u.pn = (wgid % nig) / gsz; u.z = 0; return true;
    }
    __device__ __forceinline__ size_t a_off(const Unit& u) const { return (size_t)u.pm * BM * lda; }
    __device__ __forceinline__ size_t b_off(const Unit& u) const { return (bsel_stride ? (size_t)bsel_of_pm(u.pm) * bsel_stride : 0) + (size_t)u.pn * BM * ldb; }
};
struct SchedGrouped {
    int nM, nN, nz, G, c, lda, ldb; size_t a_gs, b_gs;
    __device__ void init(int M, int N, int nz_, int G_, int c_, int lda_, int ldb_, size_t ags, size_t bgs) { nM = M / BM; nN = N / BM; nz = nz_; G = G_; c = c_; lda = lda_; ldb = ldb_; a_gs = ags; b_gs = bgs; }
    __device__ __forceinline__ bool next(int i, Unit& u) const {
        const long L = (long)i * G + c; const int per = nM * nN; const long tot = (long)nz * per; if (L >= tot) return false;
        int w = (int)L; if (tot % NXCD == 0) { const int q = (int)(tot / NXCD); w = (w % NXCD) * q + w / NXCD; }
        u.z = w / per; const int t = w % per; u.pm = t / nN; u.pn = t % nN; return true;
    }
    __device__ __forceinline__ size_t a_off(const Unit& u) const { return (size_t)u.z * a_gs + (size_t)u.pm * BM * lda; }
    __device__ __forceinline__ size_t b_off(const Unit& u) const { return (size_t)u.z * b_gs + (size_t)u.pn * BM * ldb; }
};

template <class Epi, class Sched>
__device__ __forceinline__ void gemm_phase(LAS unsigned char* lds, const Gemm g, const Sched& S, const Epi& E) {
    int tid = threadIdx.x; asm volatile("" : "+v"(tid));
    const int wid = __builtin_amdgcn_readfirstlane(tid >> 6), lane = tid & 63, wr = wid >> 2, wc = wid & 3, fr = lane & 15, fq = lane >> 4;
    const int K = g.K, nt = K / BK;
    unsigned voffA[2], voffB[2];
#pragma unroll
    for (int i = 0; i < 2; ++i) { int R, C; stage_rc(tid * 16 + i * 8192, R, C); const int Rb = (R & ~31) + perm32(R & 31);
        voffA[i] = (unsigned)(R * g.lda + C) * 2u; voffB[i] = (unsigned)(Rb * g.ldb + C) * 2u; }
    const size_t kstep = (size_t)(BK * 2);
    const size_t hsA = (size_t)HALF * g.lda * 2, hsB = (size_t)HALF * g.ldb * 2;
    const unsigned ldsw = (unsigned)wid * 1024u;
    const int aoff = lds_byte(wr * 64 + fr, fq * 8), boff = lds_byte(wc * 32 + fr, fq * 8);
#define PG8_SA(b, h) (((b) * 2 + (h)) * HTB)
#define PG8_SB(b, h) ((4 + (b) * 2 + (h)) * HTB)
#define PG8_STAGE(bufoff, gbase, voff) do { _Pragma("unroll") for (int _i = 0; _i < 2; ++_i) \
        __builtin_amdgcn_global_load_lds((const unsigned*)((const char*)(gbase) + (voff)[_i]), (LAS unsigned*)(lds + (bufoff) + ldsw + _i * 8192), 16, 0, 0); } while (0)
#define PG8_LDA(dst, b, h) do { _Pragma("unroll") for (int m = 0; m < 4; ++m) _Pragma("unroll") for (int k = 0; k < 2; ++k) dst[m][k] = *(const LAS h16x8*)(lds + PG8_SA(b, h) + aoff + m * 2048 + k * 1024); } while (0)
#define PG8_LDB(dst, b, h) do { _Pragma("unroll") for (int n = 0; n < 2; ++n) _Pragma("unroll") for (int k = 0; k < 2; ++k) dst[n][k] = *(const LAS h16x8*)(lds + PG8_SB(b, h) + boff + n * 2048 + k * 1024); } while (0)
#define PG8_MMA(ai, bj, At, Bt) do { __builtin_amdgcn_s_setprio(1); _Pragma("unroll") for (int m = 0; m < 4; ++m) _Pragma("unroll") for (int n = 0; n < 2; ++n) _Pragma("unroll") for (int k = 0; k < 2; ++k) \
        acc[ai][bj][m][n] = __builtin_amdgcn_mfma_f32_16x16x32_f16(Bt[n][k], At[m][k], acc[ai][bj][m][n], 0, 0, 0); __builtin_amdgcn_s_setprio(0); } while (0)
#define PG8_WAIT_V(n) asm volatile("s_waitcnt vmcnt(" #n ")" ::: "memory")
#define PG8_WAIT_L(n) asm volatile("s_waitcnt lgkmcnt(" #n ")" ::: "memory")
#define PG8_BAR __builtin_amdgcn_s_barrier()
#define PG8_SCHED __builtin_amdgcn_sched_barrier(0)
    Unit cur, nxt; int ui = 0;
    if (!S.next(0, cur)) return;
    f32x4 acc[2][2][4][2];
#pragma unroll
    for (int a = 0; a < 2; ++a)
#pragma unroll
        for (int b = 0; b < 2; ++b)
#pragma unroll
            for (int m = 0; m < 4; ++m)
#pragma unroll
                for (int n = 0; n < 2; ++n) acc[a][b][m][n] = (f32x4){0.f, 0.f, 0.f, 0.f};
    h16x8 At[4][2], B0[2][2], B1[2][2];
    const char* cA = (const char*)g.A + S.a_off(cur) * 2; const char* cB = (const char*)g.Bt + S.b_off(cur) * 2;
    PG8_STAGE(PG8_SB(0, 0), cB, voffB); PG8_STAGE(PG8_SB(0, 1), cB + hsB, voffB); PG8_STAGE(PG8_SA(0, 0), cA, voffA); PG8_STAGE(PG8_SA(0, 1), cA + hsA, voffA);
    if (wr == 1) PG8_BAR;
    PG8_WAIT_V(2); PG8_BAR;
    PG8_STAGE(PG8_SB(1, 0), cB + kstep, voffB); PG8_STAGE(PG8_SA(1, 0), cA + kstep, voffA); PG8_STAGE(PG8_SB(1, 1), cB + hsB + kstep, voffB);
    PG8_WAIT_V(6); PG8_BAR;
    for (;;) {
        const bool has_next = S.next(ui + 1, nxt);
        const char* nA = has_next ? (const char*)g.A + S.a_off(nxt) * 2 : cA; const char* nB = has_next ? (const char*)g.Bt + S.b_off(nxt) * 2 : cB;
        for (int t = 0; t < nt; t += 2) {
            const bool last = (t == nt - 2);
            const char* a1 = cA + (size_t)(t + 1) * kstep;
            const char* a2 = last ? nA : cA + (size_t)(t + 2) * kstep; const char* b2 = last ? nB : cB + (size_t)(t + 2) * kstep;
            const char* a3 = a2 + kstep; const char* b3 = b2 + kstep;
            PG8_LDB(B0, 0, 0); PG8_LDB(B1, 0, 1); PG8_SCHED; PG8_LDA(At, 0, 0); PG8_STAGE(PG8_SA(1, 1), a1 + hsA, voffA);
            PG8_WAIT_V(8); PG8_WAIT_L(0); PG8_BAR; PG8_MMA(0, 0, At, B0); PG8_MMA(0, 1, At, B1); PG8_BAR; PG8_SCHED;
            PG8_LDA(At, 0, 1); PG8_STAGE(PG8_SB(0, 0), b2, voffB); PG8_STAGE(PG8_SB(0, 1), b2 + hsB, voffB); PG8_STAGE(PG8_SA(0, 0), a2, voffA);
            PG8_WAIT_V(8); PG8_WAIT_L(0); PG8_BAR; PG8_MMA(1, 0, At, B0); PG8_MMA(1, 1, At, B1); PG8_BAR; PG8_SCHED;
            PG8_LDB(B0, 1, 0); PG8_LDB(B1, 1, 1); PG8_SCHED; PG8_LDA(At, 1, 0); PG8_STAGE(PG8_SA(0, 1), a2 + hsA, voffA);
            PG8_WAIT_V(8); PG8_WAIT_L(0); PG8_BAR; PG8_MMA(0, 0, At, B0); PG8_MMA(0, 1, At, B1); PG8_BAR; PG8_SCHED;
            PG8_LDA(At, 1, 1); PG8_STAGE(PG8_SB(1, 0), b3, voffB); PG8_STAGE(PG8_SB(1, 1), b3 + hsB, voffB); PG8_STAGE(PG8_SA(1, 0), a3, voffA);
            PG8_WAIT_V(8); PG8_WAIT_L(0); PG8_BAR; PG8_MMA(1, 0, At, B0); PG8_MMA(1, 1, At, B1); PG8_BAR; PG8_SCHED;
        }
        if (wr == 0) PG8_BAR;
        E(acc, cur, wr, wc, fr, fq);
        if (!has_next) break;
#pragma unroll
        for (int a = 0; a < 2; ++a)
#pragma unroll
            for (int b = 0; b < 2; ++b)
#pragma unroll
                for (int m = 0; m < 4; ++m)
#pragma unroll
                    for (int n = 0; n < 2; ++n) acc[a][b][m][n] = (f32x4){0.f, 0.f, 0.f, 0.f};
        cur = nxt; cA = nA; cB = nB; ++ui;
        if (wr == 1) PG8_BAR;
    }
    PG8_WAIT_V(0);
    PG8_BAR;
#undef PG8_SA
#undef PG8_SB
#undef PG8_STAGE
#undef PG8_LDA
#undef PG8_LDB
#undef PG8_MMA
#undef PG8_WAIT_V
#undef PG8_WAIT_L
#undef PG8_BAR
#undef PG8_SCHED
}
}

typedef f32x4 AccT[2][2][4][2];

struct EpiSsmIn {
    h16* UH; h16* Z;
    __device__ __forceinline__ void operator()(const AccT& acc, const pg8::Unit& u, int wr, int wc, int fr, int fq) const {
        const int cw = wc * 32 + 8 * fq;
#pragma unroll
        for (int ai = 0; ai < 2; ++ai)
#pragma unroll
            for (int m = 0; m < 4; ++m) {
                const int row = u.pm * 256 + ai * 128 + wr * 64 + m * 16 + fr;
#pragma unroll
                for (int bj = 0; bj < 2; ++bj) {
                    f32x4 v0 = acc[ai][bj][m][0], v1 = acc[ai][bj][m][1];
                    const int col = u.pn * 256 + bj * 128 + cw;
                    if (u.pn < 4) {
                        const int g = col >> 4, h0 = col & 15, cr = row >> 5, s = row & 31;
                        *(u32x4*)(UH + ((size_t)(g * NCHP + cr) * UHW + s * 16 + h0)) = pk8(v0, v1);
                    } else {
#pragma unroll
                        for (int e = 0; e < 4; ++e) { v0[e] = silu_f(v0[e]); v1[e] = silu_f(v1[e]); }
                        *(u32x4*)(Z + ((size_t)row * DM + (col - 1024))) = pk8(v0, v1);
                    }
                }
            }
    }
};
struct EpiS5State {
    float* S;
    __device__ __forceinline__ void operator()(const AccT& acc, const pg8::Unit& u, int wr, int wc, int fr, int fq) const {
#pragma unroll
        for (int ai = 0; ai < 2; ++ai)
#pragma unroll
            for (int m = 0; m < 4; ++m) {
                const int row = u.pm * 256 + ai * 128 + wr * 64 + m * 16 + fr;
                float* rp = S + ((size_t)(u.z * NCHP + row) * 256 + wc * 32 + 8 * fq);
#pragma unroll
                for (int bj = 0; bj < 2; ++bj) { *(f32x4*)(rp + bj * 128) = acc[ai][bj][m][0]; *(f32x4*)(rp + bj * 128 + 4) = acc[ai][bj][m][1]; }
            }
    }
};
struct EpiS5Out {
    h16* Y1;
    __device__ __forceinline__ void operator()(const AccT& acc, const pg8::Unit& u, int wr, int wc, int fr, int fq) const {
#pragma unroll
        for (int ai = 0; ai < 2; ++ai)
#pragma unroll
            for (int m = 0; m < 4; ++m) {
                const int cr = u.pm * 256 + ai * 128 + wr * 64 + m * 16 + fr;
                if (cr < NCH) {
#pragma unroll
                    for (int bj = 0; bj < 2; ++bj) {
                        const int n = u.pn * 256 + bj * 128 + wc * 32 + 8 * fq; const int s = n >> 4, h0 = n & 15;
                        const f32x4 a = acc[ai][bj][m][0], b = acc[ai][bj][m][1];
                        const f32x2 g0 = gelu_pk((f32x2){a[0], a[1]}), g1 = gelu_pk((f32x2){a[2], a[3]}), g2 = gelu_pk((f32x2){b[0], b[1]}), g3 = gelu_pk((f32x2){b[2], b[3]});
                        u32x4 w; w.x = pk2(g0.x, g0.y); w.y = pk2(g1.x, g1.y); w.z = pk2(g2.x, g2.y); w.w = pk2(g3.x, g3.y);
                        *(u32x4*)(Y1 + ((size_t)(cr * TCH + s) * DM + u.z * 16 + h0)) = w;
                    }
                }
            }
    }
};
struct EpiGlu {
    const h16* Y1; const h16* Z; const float* bglu; h16* G2;
    __device__ __forceinline__ void operator()(const AccT& acc, const pg8::Unit& u, int wr, int wc, int fr, int fq) const {
        const int cw = u.pn * 256 + wc * 32 + 8 * fq;
        f32x4 bv[2][2];
#pragma unroll
        for (int bj = 0; bj < 2; ++bj)
#pragma unroll
            for (int n = 0; n < 2; ++n) bv[bj][n] = *(const f32x4*)(bglu + cw + bj * 128 + 4 * n);
#pragma unroll
        for (int ai = 0; ai < 2; ++ai)
#pragma unroll
            for (int m = 0; m < 4; ++m) {
                const int row = u.pm * 256 + ai * 128 + wr * 64 + m * 16 + fr;
#pragma unroll
                for (int bj = 0; bj < 2; ++bj) {
                    const size_t off = (size_t)row * DM + cw + bj * 128;
                    float y[8], z[8]; unpack8(Y1 + off, y); unpack8(Z + off, z);
                    f32x4 v0 = acc[ai][bj][m][0] + bv[bj][0], v1 = acc[ai][bj][m][1] + bv[bj][1];
#pragma unroll
                    for (int e = 0; e < 4; ++e) { v0[e] = y[e] * sigm_f(v0[e]) * z[e]; v1[e] = y[4 + e] * sigm_f(v1[e]) * z[4 + e]; }
                    *(u32x4*)(G2 + off) = pk8(v0, v1);
                }
            }
    }
};
template <bool IN16>
struct EpiOut {
    const float* xin; const float* xin_ctx; const h16* xin16; const float* gate;   h16* xout16; h16* xh; const float* xhf;   float* ssq;
    __device__ __forceinline__ void operator()(const AccT& acc, const pg8::Unit& u, int wr, int wc, int fr, int fq) const {
        const int bs = bsel_of_pm(u.pm); const int cw = u.pn * 256 + wc * 32 + 8 * fq;
        const float* gp = gate + bs * 3072 + cw;
#pragma unroll
        for (int ai = 0; ai < 2; ++ai)
#pragma unroll
            for (int m = 0; m < 4; ++m) {
                const int row = u.pm * 256 + ai * 128 + wr * 64 + m * 16 + fr;
                float sq = 0.f;
#pragma unroll
                for (int bj = 0; bj < 2; ++bj) {
                    const int col = cw + bj * 128;
                    const f32x4 g0 = *(const f32x4*)(gp + bj * 128), g1 = *(const f32x4*)(gp + bj * 128 + 4);
                    f32x4 x0, x1;
                    if (IN16) { float xv[8]; unpack8(xin16 + (size_t)row * DM + col, xv); x0 = (f32x4){xv[0], xv[1], xv[2], xv[3]}; x1 = (f32x4){xv[4], xv[5], xv[6], xv[7]}; }
                    else { const float* xr = (row < NTOK) ? xin + (size_t)row * DM : xin_ctx + (size_t)(row - NTOK) * DM; x0 = *(const f32x4*)(xr + col); x1 = *(const f32x4*)(xr + col + 4); }
                    const f32x4 o0 = x0 + g0 * acc[ai][bj][m][0], o1 = x1 + g1 * acc[ai][bj][m][1];
                    *(u32x4*)(xout16 + (size_t)row * DM + col) = pk8(o0, o1);
                    if (xh) { const f32x4 f0 = *(const f32x4*)(xhf + bs * 1024 + col), f1 = *(const f32x4*)(xhf + bs * 1024 + col + 4); *(u32x4*)(xh + (size_t)row * DM + col) = pk8(o0 * f0, o1 * f1); }
#pragma unroll
                    for (int e = 0; e < 4; ++e) sq += o0[e] * o0[e] + o1[e] * o1[e];
                }
                sq += __shfl_xor(sq, 16); sq += __shfl_xor(sq, 32);
                if (fq == 0) ssq[(size_t)row * 16 + u.pn * 4 + wc] = sq;
            }
    }
};
struct EpiAttnIn {
    const float* ssq; const float* bias; const float* qn; const float* kn; const float* ropec; const float* ropes;
    h16* Q; h16* Kb; h16* Vt; h16* Z;
    __device__ __forceinline__ void operator()(const AccT& acc, const pg8::Unit& u, int wr, int wc, int fr, int fq) const {
        const int bs = bsel_of_pm(u.pm); const int cw = wc * 32 + 8 * fq;
        const float* bp = bias + bs * 2560 + u.pn * 256 + cw;
        const bool is_ctx = (u.pm >= 256);
        if (is_ctx && (u.pn < 4 || u.pn >= 6)) return;
        f32x4 bv[2][2];
#pragma unroll
        for (int bj = 0; bj < 2; ++bj)
#pragma unroll
            for (int n = 0; n < 2; ++n) bv[bj][n] = *(const f32x4*)(bp + bj * 128 + 4 * n);
        if (u.pn < 5) {
            const float* nwp = (u.pn < 4) ? qn : kn;
            const int dlo = 32 * (fq >> 1) + 8 * (fq & 1);
            f32x4 nw[2][2];
#pragma unroll
            for (int bj = 0; bj < 2; ++bj)
#pragma unroll
                for (int n = 0; n < 2; ++n) nw[bj][n] = *(const f32x4*)(nwp + dlo + 16 * bj + 4 * n);
            const float osc = (u.pn < 4) ? QSCALE : 1.0f;
#pragma unroll
            for (int ai = 0; ai < 2; ++ai)
#pragma unroll
                for (int m = 0; m < 4; ++m) {
                    const int row = u.pm * 256 + ai * 128 + wr * 64 + m * 16 + fr;
                    const f32x4 s0 = *(const f32x4*)(ssq + (size_t)row * 16), s1 = *(const f32x4*)(ssq + (size_t)row * 16 + 4), s2 = *(const f32x4*)(ssq + (size_t)row * 16 + 8), s3 = *(const f32x4*)(ssq + (size_t)row * 16 + 12);
                    const f32x4 st = (s0 + s1) + (s2 + s3);
                    const float rstd = __builtin_amdgcn_rsqf(((st[0] + st[1]) + (st[2] + st[3])) * (1.0f / 1024.0f) + EPS);
                    f32x4 v[2][2]; float sq = 0.f;
#pragma unroll
                    for (int bj = 0; bj < 2; ++bj)
#pragma unroll
                        for (int n = 0; n < 2; ++n) { v[bj][n] = acc[ai][bj][m][n] * rstd + bv[bj][n];
#pragma unroll
                            for (int e = 0; e < 4; ++e) sq += v[bj][n][e] * v[bj][n][e]; }
                    sq += __shfl_xor(sq, 16); sq += __shfl_xor(sq, 32);
                    const float rn = __builtin_amdgcn_rsqf(sq * (1.0f / 64.0f) + EPS) ;
                    f32x4 o[2][2];
                    if (!is_ctx) {
                        const int t = row & (SEQ - 1); const int pos = (fq >> 1) ? (t & 63) : (t >> 6);
                        const float* cp = ropec + pos * 16 + 8 * (fq & 1); const float* sp = ropes + pos * 16 + 8 * (fq & 1);
#pragma unroll
                        for (int n = 0; n < 2; ++n) {
                            const f32x4 cs = *(const f32x4*)(cp + 4 * n), sn = *(const f32x4*)(sp + 4 * n);
                            const f32x4 x1 = v[0][n] * rn * nw[0][n], x2 = v[1][n] * rn * nw[1][n];
                            o[0][n] = (x1 * cs - x2 * sn) * osc; o[1][n] = (x2 * cs + x1 * sn) * osc;
                        }
                    } else {
#pragma unroll
                        for (int n = 0; n < 2; ++n) { o[0][n] = v[0][n] * rn * nw[0][n]; o[1][n] = v[1][n] * rn * nw[1][n]; }
                    }
                    if (u.pn < 4) {
                        h16* qp = Q + (size_t)row * DM + (4 * u.pn + wc) * 64 + dlo;
                        *(u32x4*)(qp) = pk8(o[0][0], o[0][1]); *(u32x4*)(qp + 16) = pk8(o[1][0], o[1][1]);
                    } else {
                        int b, key; if (!is_ctx) { b = row >> 13; key = row & (SEQ - 1); } else { const int rc = row - NTOK; b = rc >> 8; key = SEQ + (rc & 255); }
                        h16* kp = Kb + ((size_t)((b * 4 + wc) * KVL + key)) * 64 + dlo;
                        *(u32x4*)(kp) = pk8(o[0][0], o[0][1]); *(u32x4*)(kp + 16) = pk8(o[1][0], o[1][1]);
                    }
                }
        } else {
#pragma unroll
            for (int ai = 0; ai < 2; ++ai)
#pragma unroll
                for (int m = 0; m < 4; ++m) {
                    const int row = u.pm * 256 + ai * 128 + wr * 64 + m * 16 + fr;
                    const f32x4 s0 = *(const f32x4*)(ssq + (size_t)row * 16), s1 = *(const f32x4*)(ssq + (size_t)row * 16 + 4), s2 = *(const f32x4*)(ssq + (size_t)row * 16 + 8), s3 = *(const f32x4*)(ssq + (size_t)row * 16 + 12);
                    const f32x4 st = (s0 + s1) + (s2 + s3);
                    const float rstd = __builtin_amdgcn_rsqf(((st[0] + st[1]) + (st[2] + st[3])) * (1.0f / 1024.0f) + EPS);
#pragma unroll
                    for (int bj = 0; bj < 2; ++bj) {
                        f32x4 v0 = acc[ai][bj][m][0] * rstd + bv[bj][0], v1 = acc[ai][bj][m][1] * rstd + bv[bj][1];
                        if (u.pn == 5) {
                            int b, key; if (!is_ctx) { b = row >> 13; key = row & (SEQ - 1); } else { const int rc = row - NTOK; b = rc >> 8; key = SEQ + (rc & 255); }
                            const int g = bj * 2 + (wc >> 1), d0 = (wc & 1) * 32 + 8 * fq;
                            h16* vp = Vt + ((size_t)((b * 4 + g) * 64 + d0)) * KVL + key;
#pragma unroll
                            for (int e = 0; e < 4; ++e) { vp[(size_t)e * KVL] = (h16)v0[e]; vp[(size_t)(4 + e) * KVL] = (h16)v1[e]; }
                        } else {
#pragma unroll
                            for (int e = 0; e < 4; ++e) { v0[e] = silu_f(v0[e]); v1[e] = silu_f(v1[e]); }
                            *(u32x4*)(Z + (size_t)row * DM + (u.pn - 6) * 256 + bj * 128 + cw) = pk8(v0, v1);
                        }
                    }
                }
        }
    }
};

__device__ __forceinline__ int attn_srccol(int np);
template <bool ATTN>
__device__ __forceinline__ void tr_plain_item(const float* W, int N, h16* WT, LAS float* scr, int item, int lane) {
    const int nblk = N / 32, kb = item / nblk, nb = item % nblk, k0 = 64 * kb, n0 = 32 * nb;
    const int sc = ATTN ? attn_srccol(n0 + (lane & 31)) : (n0 + (lane & 31));
#pragma unroll 8
    for (int i = 0; i < 32; ++i) { const int kk = 2 * i + (lane >> 5); scr[kk * 33 + (lane & 31)] = W[(size_t)(k0 + kk) * N + sc]; }
    const int c = lane & 7;
#pragma unroll
    for (int j = 0; j < 4; ++j) { const int n = (lane >> 3) + 8 * j; const LAS float* s = scr + (8 * c) * 33 + n;
        u32x4 o; o.x = pk2(s[0 * 33], s[1 * 33]); o.y = pk2(s[2 * 33], s[3 * 33]); o.z = pk2(s[4 * 33], s[5 * 33]); o.w = pk2(s[6 * 33], s[7 * 33]);
        *(u32x4*)(WT + (size_t)(n0 + n) * 1024 + k0 + 8 * c) = o; }
}
__device__ __forceinline__ int attn_srccol(int np) {
    if (np >= 1280) return np;
    const int pn = np >> 8, nn = np & 255, bj = nn >> 7, wc = (nn >> 5) & 3, fq = (nn >> 3) & 3, j = nn & 7;
    return pn * 256 + 64 * wc + 32 * (fq >> 1) + 16 * bj + 8 * (fq & 1) + j;
}
template <int MODE>
__device__ __forceinline__ void gemv9_task(const Params& P, const float* W, int N, int col0, const float* modl, float* out, int ostride, int ocol, const float* addv, int lane) {
    f32x4 a[9];
#pragma unroll
    for (int b = 0; b < 9; ++b) a[b] = (f32x4){0.f, 0.f, 0.f, 0.f};
    for (int j = 0; j < 16; ++j) {
        const int k = lane + 64 * j;
        const f32x4 w = *(const f32x4*)(W + (size_t)k * N + col0);
#pragma unroll
        for (int b = 0; b < 9; ++b) {
            float sv;
            if (MODE == 0) { const float cv = (b < 8) ? P.c[b * DM + k] : P.c_ctx[k]; sv = silu_f(cv); }
            else sv = modl[b * 3072 + k];
            a[b] += w * sv;
        }
    }
#pragma unroll
    for (int b = 0; b < 9; ++b) {
#pragma unroll
        for (int e = 0; e < 4; ++e) a[b][e] = wave_sum(a[b][e]);
    }
    if (lane == 0) {
#pragma unroll
        for (int b = 0; b < 9; ++b) { f32x4 r = a[b]; if (addv) r += *(const f32x4*)(addv + ocol); *(f32x4*)(out + (size_t)b * ostride + ocol) = r; }
    }
}

__device__ __forceinline__ void s5_tables(const Params& P, int g, int qt, LAS unsigned char* lds) {
    LAS f32x2* E = (LAS f32x2*)lds;
    LAS f32x2* Bb = (LAS f32x2*)(lds + 33792);
    LAS f32x2* Cc = (LAS f32x2*)(lds + 50176);
    LAS float* Kt = (LAS float*)(lds + 66816);
    const int tid = threadIdx.x;
    for (int idx = tid; idx < 2 * 64 * 33; idx += 512) {
        const int d = idx / 2112, rem = idx % 2112, p = rem / 33, k = rem % 33;
        const float dt = expf(P.log_dt[d * 64 + g]); const float ar = P.a_re[(d * 64 + g) * 64 + p], ai = P.a_im[(d * 64 + g) * 64 + p];
        const float re = ar * dt * (float)k, im = ai * dt * (float)k; const float mg = expf(re);
        E[idx] = (f32x2){mg * cosf(im), mg * sinf(im)};
    }
    for (int idx = tid; idx < 2048; idx += 512) {
        const int d = idx >> 10, p = (idx >> 4) & 63, h = idx & 15;
        const float dt = expf(P.log_dt[d * 64 + g]); const float ar = P.a_re[(d * 64 + g) * 64 + p], ai = P.a_im[(d * 64 + g) * 64 + p];
        const float zr = ar * dt, zi = ai * dt; const float er = expm1f(zr), cz = cosf(zi), sz = sinf(zi), sh = sinf(0.5f * zi);
        const float nr = er * cz - 2.0f * sh * sh, ni = (er + 1.0f) * sz;
        const float den = 1.0f / (ar * ar + ai * ai); const float qr = (nr * ar + ni * ai) * den, qi = (ni * ar - nr * ai) * den;
        const float br = P.b_re[((size_t)(d * 64 + g) * 64 + p) * 16 + h], bi = P.b_im[((size_t)(d * 64 + g) * 64 + p) * 16 + h];
        Bb[idx] = (f32x2){qr * br - qi * bi, qr * bi + qi * br};
    }
    for (int idx = tid; idx < 2048; idx += 512) {
        const int d = idx >> 10, h = (idx >> 6) & 15, p = idx & 63;
        Cc[(d * 16 + h) * 65 + p] = (f32x2){P.c_re[((size_t)(d * 64 + g) * 16 + h) * 64 + p], P.c_im[((size_t)(d * 64 + g) * 16 + h) * 64 + p]};
    }
    __syncthreads();
    for (int t = tid; t < 1024; t += 512) {
        const int d = t >> 9, k = (t >> 4) & 31, h = t & 15;
        float a[16];
#pragma unroll
        for (int e = 0; e < 16; ++e) a[e] = 0.f;
        for (int p = 0; p < 64; ++p) {
            const f32x2 cc = Cc[(d * 16 + h) * 65 + p], ee = E[(d * 64 + p) * 33 + k];
            const float cr = cc.x * ee.x - cc.y * ee.y, ci = cc.x * ee.y + cc.y * ee.x;
            const LAS f32x4* bp = (const LAS f32x4*)(Bb + (d * 64 + p) * 16);
#pragma unroll
            for (int e = 0; e < 8; ++e) { const f32x4 b2 = bp[e]; a[2 * e] += cr * b2[0] - ci * b2[1]; a[2 * e + 1] += cr * b2[2] - ci * b2[3]; }
        }
        LAS f32x4* kp = (LAS f32x4*)(Kt + ((d * 32 + k) * 16 + h) * 16);
#pragma unroll
        for (int e = 0; e < 4; ++e) kp[e] = (f32x4){a[4 * e], a[4 * e + 1], a[4 * e + 2], a[4 * e + 3]};
    }
    __syncthreads();
    h16* W2 = (h16*)(P.ws + WS_W2S) + (size_t)g * 512 * 768;
    for (int idx = qt * 12288 + tid; idx < (qt + 1) * 12288; idx += 512) {
        const int n = idx / 96, kc = idx % 96, k0 = 8 * kc, s = n >> 4, h = n & 15;
        float v[8];
        if (k0 < 512) {
            const int sp = k0 >> 4, hp0 = k0 & 15;
#pragma unroll
            for (int e = 0; e < 8; ++e) {
                const int hp = hp0 + e; float val;
                if (sp < s) val = Kt[((0 * 32 + (s - sp)) * 16 + h) * 16 + hp];
                else if (sp > s) val = Kt[((1 * 32 + (sp - s)) * 16 + h) * 16 + hp];
                else { val = Kt[((0 * 32) * 16 + h) * 16 + hp] + Kt[((1 * 32) * 16 + h) * 16 + hp]; if (hp == h) val += P.ssm_d[g * 16 + h]; }
                v[e] = val;
            }
        } else {
            const int kk0 = k0 - 512, d = kk0 >> 7, p0 = (kk0 >> 1) & 63; const int ke = d == 0 ? s + 1 : 32 - s;
#pragma unroll
            for (int e = 0; e < 4; ++e) {
                const f32x2 cc = Cc[(d * 16 + h) * 65 + p0 + e], ee = E[(d * 64 + p0 + e) * 33 + ke];
                v[2 * e] = cc.x * ee.x - cc.y * ee.y; v[2 * e + 1] = -(cc.x * ee.y + cc.y * ee.x);
            }
        }
        u32x4 o; o.x = pk2(v[0], v[1]); o.y = pk2(v[2], v[3]); o.z = pk2(v[4], v[5]); o.w = pk2(v[6], v[7]);
        *(u32x4*)(W2 + (size_t)n * 768 + k0) = o;
    }
    h16* W1 = (h16*)(P.ws + WS_W1S) + (size_t)g * 256 * 512;
    for (int idx = qt * 4096 + tid; idx < (qt + 1) * 4096; idx += 512) {
        const int n = idx >> 6, k0 = 8 * (idx & 63), d = n >> 7, p = (n >> 1) & 63, ri = n & 1, sp = k0 >> 4, hp0 = k0 & 15;
        const f32x2 ee = E[(d * 64 + p) * 33 + (d == 0 ? 31 - sp : sp)];
        float v[8];
#pragma unroll
        for (int e = 0; e < 8; ++e) { const f32x2 bb = Bb[(d * 64 + p) * 16 + hp0 + e]; v[e] = ri == 0 ? (ee.x * bb.x - ee.y * bb.y) : (ee.x * bb.y + ee.y * bb.x); }
        u32x4 o; o.x = pk2(v[0], v[1]); o.y = pk2(v[2], v[3]); o.z = pk2(v[4], v[5]); o.w = pk2(v[6], v[7]);
        *(u32x4*)(W1 + (size_t)n * 512 + k0) = o;
    }
    __syncthreads();
}

__device__ __forceinline__ void norm_row_h16(const float* xrow, const float* gvec, const float* modrow, h16* orow, int lane) {
    const f32x4* xr = (const f32x4*)xrow + lane; f32x4 v[4]; float s = 0.f;
#pragma unroll
    for (int j = 0; j < 4; ++j) { v[j] = xr[64 * j]; s += (v[j][0] * v[j][0] + v[j][1] * v[j][1]) + (v[j][2] * v[j][2] + v[j][3] * v[j][3]); }
    const float rstd = 1.0f / sqrtf(wave_sum(s) * (1.0f / DM) + EPS);
    u32x2* o8 = (u32x2*)orow + lane;
#pragma unroll
    for (int j = 0; j < 4; ++j) { const f32x4 gg = ((const f32x4*)gvec)[lane + 64 * j], sc = ((const f32x4*)(modrow + 1024))[lane + 64 * j], sh = ((const f32x4*)modrow)[lane + 64 * j];
        const f32x4 w = v[j] * rstd * gg * (sc + 1.0f) + sh; u32x2 o; o.x = pk2(w[0], w[1]); o.y = pk2(w[2], w[3]); o8[64 * j] = o; }
}

__device__ __forceinline__ void scan_phase(const Params& P) {
    const int gid = blockIdx.x * 512 + threadIdx.x;
    const int nthr = gridDim.x * 512;
    const float* __restrict__ S = (const float*)(P.ws + WS_X1);
    h16* __restrict__ UH = (h16*)(P.ws + WS_UH);
    for (int id = gid; id < NB * 64 * 2 * 64; id += nthr) {
        const int p = id & 63, d = (id >> 6) & 1, g = (id >> 7) & 63, b = id >> 13;
        const float dt = expf(P.log_dt[d * 64 + g]); const float ar = P.a_re[(d * 64 + g) * 64 + p], ai = P.a_im[(d * 64 + g) * 64 + p];
        const float mg = expf(ar * dt * (float)TCH), an = ai * dt * (float)TCH; const float tr = mg * cosf(an), ti = mg * sinf(an);
        float hr = 0.f, hi = 0.f;
        const size_t colS = (size_t)d * 128 + 2 * p, colH = 512 + (size_t)d * 128 + 2 * p;
        for (int q = 0; q < 8; ++q) {
            const int cc = d == 0 ? q : 7 - q; const size_t row = (size_t)g * NCHP + 2048 + b * 8 + cc;
            const f32x2 sv = *(const f32x2*)(S + row * 256 + colS);
            *(unsigned*)(UH + row * UHW + colH) = pk2(hr, hi);
            const float nr = tr * hr - ti * hi + sv.x, ni = tr * hi + ti * hr + sv.y; hr = nr; hi = ni;
        }
        for (int q0 = 0; q0 < 256; q0 += 8) {
            f32x2 sv[8];
#pragma unroll
            for (int e = 0; e < 8; ++e) { const int cq = d == 0 ? q0 + e : 255 - q0 - e; sv[e] = *(const f32x2*)(S + ((size_t)g * NCHP + b * 256 + cq) * 256 + colS); }
#pragma unroll
            for (int e = 0; e < 8; ++e) {
                const int cq = d == 0 ? q0 + e : 255 - q0 - e; const size_t row = (size_t)g * NCHP + b * 256 + cq;
                *(unsigned*)(UH + row * UHW + colH) = pk2(hr, hi);
                const float nr = tr * hr - ti * hi + sv[e].x, ni = tr * hi + ti * hr + sv[e].y; hr = nr; hi = ni;
            }
        }
    }
}

__device__ __forceinline__ int attn_crow(int r, int hi) { return (r & 3) + 8 * (r >> 2) + 4 * hi; }
template <bool ADDC>
__device__ __forceinline__ void attn_units(const Params& P, LAS unsigned char* lds, const float cadd) {
    int tid = threadIdx.x; asm volatile("" : "+v"(tid));
    const int lane = tid & 63, wid = __builtin_amdgcn_readfirstlane(tid >> 6), r32 = lane & 31, hi = lane >> 5;
    const h16* Q = (const h16*)(P.ws + WS_UH); const h16* Kb = (const h16*)(P.ws + WS_K); const h16* Vt = (const h16*)(P.ws + WS_VT);
    const h16* Z = (const h16*)(P.ws + WS_BUFZ); h16* OG = (h16*)(P.ws + WS_BUFA);
    LAS float* lsc = (LAS float*)(lds + 131072) + wid * 64;
    const int drow = 8 * wid + (lane >> 3), dchk = (lane & 7) ^ ((drow >> 1) & 7);
    const unsigned kdoff = (unsigned)(drow * 128 + dchk * 16), vdoff = (unsigned)((drow * KVL + dchk * 8) * 2);
    int kro[2], krx[2], vro[2], vrx[2];
#pragma unroll
    for (int kh = 0; kh < 2; ++kh) {
        const int i = r32 & 15; const int pr = (r32 & 16) | (i & 3) | ((i & 4) << 1) | ((i & 8) >> 1);
        const int row = 32 * kh + pr; kro[kh] = row * 128; krx[kh] = (row >> 1) & 7;
        const int dr = 32 * kh + r32; vro[kh] = dr * 128; vrx[kh] = (dr >> 1) & 7;
    }
    const f32x16 zero16 = {0.f, 0.f, 0.f, 0.f, 0.f, 0.f, 0.f, 0.f, 0.f, 0.f, 0.f, 0.f, 0.f, 0.f, 0.f, 0.f};
    for (int u = blockIdx.x; u < 2048; u += gridDim.x) {
        const int xx = u & 7, jj = u >> 3, bg = xx + 8 * (jj >> 6), qblk = jj & 63;
        const int b = bg >> 2, g = bg & 3, hh = 4 * g + (wid & 3), tok = qblk * 128 + (wid >> 2) * 64;
        h16x8 qr[2][4];
#pragma unroll
        for (int rb = 0; rb < 2; ++rb) { const h16* qp = Q + ((size_t)(b * SEQ + tok + 32 * rb + r32)) * DM + hh * 64 + hi * 8;
#pragma unroll
            for (int d0 = 0; d0 < 4; ++d0) qr[rb][d0] = *(const h16x8*)(qp + 16 * d0); }
        const char* kbase = (const char*)(Kb + (size_t)bg * KVL * 64);
        const char* vbase = (const char*)(Vt + (size_t)bg * 64 * KVL);
        f32x16 o00 = zero16, o01 = zero16, o10 = zero16, o11 = zero16;
        float lsum0 = 0.f, lsum1 = 0.f;
#define ATT_DMA(sg_, slot_) do { const int t0_ = 4 * (sg_); LAS unsigned char* d_ = lds + (slot_) * 65536 + wid * 1024; \
        _Pragma("unroll 1") for (int q_ = 0; q_ < 4; ++q_) { \
            __builtin_amdgcn_global_load_lds((const unsigned*)(kbase + (size_t)(t0_ + q_) * 8192 + kdoff), (LAS unsigned*)(d_ + q_ * 8192), 16, 0, 0); \
            __builtin_amdgcn_global_load_lds((const unsigned*)(vbase + (size_t)(t0_ + q_) * 128 + vdoff), (LAS unsigned*)(d_ + 32768 + q_ * 8192), 16, 0, 0); } } while (0)
        ATT_DMA(0, 0);
#pragma unroll
        for (int rb = 0; rb < 2; ++rb)
#pragma unroll
            for (int d0 = 0; d0 < 4; ++d0) asm volatile("" :: "v"(qr[rb][d0]));
        asm volatile("s_waitcnt vmcnt(0)" ::: "memory"); __builtin_amdgcn_s_barrier(); asm volatile("" ::: "memory");
        for (int sg = 0; sg < 33; ++sg) {
            const int slot = sg & 1;
            if (wid & 4) __builtin_amdgcn_s_sleep(6);
            if (sg + 1 < 33) ATT_DMA(sg + 1, slot ^ 1);
#pragma unroll 1
            for (int j = 0; j < 4; ++j) {
                const LAS unsigned char* kb = lds + slot * 65536 + j * 8192; const LAS unsigned char* vb = kb + 32768;
                f32x16 s00, s01, s10, s11;
#pragma unroll
                for (int d0 = 0; d0 < 4; ++d0) {
                    const h16x8 a0 = *(const LAS h16x8*)(kb + kro[0] + (((2 * d0 + hi) ^ krx[0]) << 4));
                    const h16x8 a1 = *(const LAS h16x8*)(kb + kro[1] + (((2 * d0 + hi) ^ krx[1]) << 4));
                    s00 = __builtin_amdgcn_mfma_f32_32x32x16_f16(a0, qr[0][d0], d0 == 0 ? zero16 : s00, 0, 0, 0);
                    s10 = __builtin_amdgcn_mfma_f32_32x32x16_f16(a0, qr[1][d0], d0 == 0 ? zero16 : s10, 0, 0, 0);
                    s01 = __builtin_amdgcn_mfma_f32_32x32x16_f16(a1, qr[0][d0], d0 == 0 ? zero16 : s01, 0, 0, 0);
                    s11 = __builtin_amdgcn_mfma_f32_32x32x16_f16(a1, qr[1][d0], d0 == 0 ? zero16 : s11, 0, 0, 0);
                }
#pragma unroll
                for (int ks = 0; ks < 4; ++ks) {
                    float p0[8], p1[8];
#pragma unroll
                    for (int e = 0; e < 8; ++e) {
                        float v0 = ks < 2 ? s00[8 * (ks & 1) + e] : s01[8 * (ks & 1) + e];
                        float v1 = ks < 2 ? s10[8 * (ks & 1) + e] : s11[8 * (ks & 1) + e];
                        if (ADDC) { v0 += cadd; v1 += cadd; }
                        p0[e] = __builtin_amdgcn_exp2f(v0); p1[e] = __builtin_amdgcn_exp2f(v1);
                    }
                    lsum0 += ((p0[0] + p0[1]) + (p0[2] + p0[3])) + ((p0[4] + p0[5]) + (p0[6] + p0[7]));
                    lsum1 += ((p1[0] + p1[1]) + (p1[2] + p1[3])) + ((p1[4] + p1[5]) + (p1[6] + p1[7]));
                    u32x4 w0, w1;
                    w0.x = pk2(p0[0], p0[1]); w0.y = pk2(p0[2], p0[3]); w0.z = pk2(p0[4], p0[5]); w0.w = pk2(p0[6], p0[7]);
                    w1.x = pk2(p1[0], p1[1]); w1.y = pk2(p1[2], p1[3]); w1.z = pk2(p1[4], p1[5]); w1.w = pk2(p1[6], p1[7]);
                    const h16x8 pa0 = __builtin_bit_cast(h16x8, w0), pa1 = __builtin_bit_cast(h16x8, w1);
                    const h16x8 b0 = *(const LAS h16x8*)(vb + vro[0] + (((2 * ks + hi) ^ vrx[0]) << 4));
                    const h16x8 b1 = *(const LAS h16x8*)(vb + vro[1] + (((2 * ks + hi) ^ vrx[1]) << 4));
                    o00 = __builtin_amdgcn_mfma_f32_32x32x16_f16(pa0, b0, o00, 0, 0, 0);
                    o10 = __builtin_amdgcn_mfma_f32_32x32x16_f16(pa1, b0, o10, 0, 0, 0);
                    o01 = __builtin_amdgcn_mfma_f32_32x32x16_f16(pa0, b1, o01, 0, 0, 0);
                    o11 = __builtin_amdgcn_mfma_f32_32x32x16_f16(pa1, b1, o11, 0, 0, 0);
                }
            }
            asm volatile("s_waitcnt vmcnt(0) lgkmcnt(0)" ::: "memory"); __builtin_amdgcn_s_barrier(); asm volatile("" ::: "memory");
        }
        lsum0 += __shfl_xor(lsum0, 32); lsum1 += __shfl_xor(lsum1, 32);
        if (hi == 0) { lsc[r32] = lsum0; lsc[32 + r32] = lsum1; }
        __builtin_amdgcn_s_waitcnt(0xc07f);
        asm volatile("" ::: "memory");
#pragma unroll
        for (int r = 0; r < 16; ++r) {
            const int q = attn_crow(r, hi); const float li0 = 1.0f / lsc[q], li1 = 1.0f / lsc[32 + q];
            const size_t off0 = ((size_t)(b * SEQ + tok + q)) * DM + hh * 64 + r32, off1 = off0 + (size_t)32 * DM;
            OG[off0] = (h16)(o00[r] * li0 * (float)Z[off0]); OG[off0 + 32] = (h16)(o01[r] * li0 * (float)Z[off0 + 32]);
            OG[off1] = (h16)(o10[r] * li1 * (float)Z[off1]); OG[off1 + 32] = (h16)(o11[r] * li1 * (float)Z[off1 + 32]);
        }
    }
}
__device__ __forceinline__ void attn_phase(const Params& P, LAS unsigned char* lds) {
    const int lane = threadIdx.x & 63;
    const float mq = wave_max(fabsf(P.q_norm[lane])), mk = wave_max(fabsf(P.k_norm[lane]));
    const float M = 8.0f * mq * mk;
    if (M <= 10.5f) attn_units<false>(P, lds, 0.f);
    else attn_units<true>(P, lds, -((M - 10.5f) * LOG2E));
}

constexpr size_t WS_BAR = 640 * 1024;
#define XB_TMO      128
#define XB_XCNT(j)  (256  + 64 * (j))
#define XB_XSUB(j)  (1280 + 64 * (j))
#define XB_XGEN(j)  (2304 + 64 * (j))
#define XB_TOP      3328
#define XB_TOPGEN   3392
#define XCD_BAR_WORDS 3456
#define XB_SPIN_CAP (1u << 18)
__device__ __forceinline__ unsigned xb_ld(unsigned* p)              { return __hip_atomic_load(p, __ATOMIC_RELAXED, __HIP_MEMORY_SCOPE_AGENT); }
__device__ __forceinline__ unsigned xb_add(unsigned* p, unsigned v) { return __hip_atomic_fetch_add(p, v, __ATOMIC_RELAXED, __HIP_MEMORY_SCOPE_AGENT); }
__device__ __forceinline__ unsigned xb_xcc_id() { return (unsigned)__builtin_amdgcn_s_getreg((3 << 11) | 20) & 0xFu; }
#define XB_SPIN(cond, bar) do { unsigned _sp = 0; while (cond) { __builtin_amdgcn_s_sleep(1); \
    if ((++_sp & 255u) == 0u) { if (xb_ld(&(bar)[XB_TMO])) break; if (_sp > XB_SPIN_CAP) { atomicAdd(&(bar)[XB_TMO], 1u); break; } } } } while (0)
struct XcdBarrier { unsigned* bar; unsigned x; volatile LAS unsigned* st; };
__device__ __forceinline__ XcdBarrier xcd_barrier_post(unsigned* bar, volatile LAS unsigned* st) {
    XcdBarrier b; b.bar = bar; b.x = xb_xcc_id(); b.st = st;
    if (threadIdx.x == 0) (void)xb_add(&bar[XB_XCNT(b.x)], 1u);
    return b;
}
__device__ __forceinline__ void xcd_barrier_complete(unsigned* bar, unsigned x, unsigned& nloc, unsigned& nx) {
    const unsigned G = gridDim.x * gridDim.y * gridDim.z;
    unsigned sum, cnt, mine, sp = 0u;
    for (;;) {
        sum = 0u; cnt = 0u; mine = 0u;
#pragma unroll
        for (unsigned j = 0; j < 16; ++j) { const unsigned c = xb_ld(&bar[XB_XCNT(j)]); sum += c; cnt += (c > 0u) ? 1u : 0u; mine = (j == x) ? c : mine; }
        if (sum == G) break;
        __builtin_amdgcn_s_sleep(1);
        if ((++sp & 255u) == 0u) { if (xb_ld(&bar[XB_TMO])) break; if (sp > XB_SPIN_CAP) { atomicAdd(&bar[XB_TMO], 1u); break; } }
    }
    nloc = mine > 0u ? mine : 1u; nx = cnt > 0u ? cnt : 1u;
}
__device__ __forceinline__ void xcd_barrier(const XcdBarrier& b) {
    asm volatile("s_waitcnt vmcnt(0)" ::: "memory");
    __syncthreads();
    if (threadIdx.x == 0) {
        unsigned* bar = b.bar;
        __builtin_amdgcn_s_waitcnt(0);
        unsigned nloc = b.st[0], nx = b.st[1];
        if (nloc == 0u) { xcd_barrier_complete(bar, b.x, nloc, nx); b.st[0] = nloc; b.st[1] = nx; }
        const unsigned old = xb_add(&bar[XB_XSUB(b.x)], 1u);
        const unsigned gen = old / nloc;
        if (old + 1u == (gen + 1u) * nloc) {
            __builtin_amdgcn_fence(__ATOMIC_RELEASE, "agent");
            asm volatile("s_waitcnt vmcnt(0)" ::: "memory");
            const unsigned og = xb_add(&bar[XB_TOP], 1u);
            const unsigned tg = og / nx;
            if (og + 1u == (tg + 1u) * nx) xb_add(&bar[XB_TOPGEN], 1u);
            else XB_SPIN(xb_ld(&bar[XB_TOPGEN]) == tg, bar);
            __builtin_amdgcn_fence(__ATOMIC_ACQUIRE, "agent");
            xb_add(&bar[XB_XGEN(b.x)], 1u);
            asm volatile("s_waitcnt vmcnt(0)" ::: "memory");
        } else {
            XB_SPIN(xb_ld(&bar[XB_XGEN(b.x)]) == gen, bar);
            __builtin_amdgcn_fence(__ATOMIC_ACQUIRE, "agent");
            asm volatile("s_waitcnt vmcnt(0)" ::: "memory");
        }
    }
    __syncthreads();
}

__global__ void __launch_bounds__(512) fwd_megakernel(Params P) {
    extern __shared__ __attribute__((aligned(16))) unsigned char lds_raw[];
    LAS unsigned char* lds = (LAS unsigned char*)lds_raw;
    cg::grid_group grid = cg::this_grid();
    const int G = gridDim.x, bx = blockIdx.x;
    unsigned char* ws = P.ws;
    float* MOD = (float*)(ws + WS_MOD);
#define THREAD_IDS int tid = threadIdx.x; asm volatile("" : "+v"(tid)); const int lane = tid & 63, wave = __builtin_amdgcn_readfirstlane(tid >> 6); const int gw = bx * 8 + wave, NGW = G * 8; LAS float* scr = (LAS float*)(lds + wave * 16384); (void)scr; (void)lane; (void)gw; (void)NGW; (void)tid;

    volatile LAS unsigned* bst = (volatile LAS unsigned*)(lds + LDS_BYTES - 64);
    if (threadIdx.x == 0) { bst[0] = 0u; bst[1] = 0u; }
    if (bx == 0) for (int i = threadIdx.x; i < XCD_BAR_WORDS; i += 512) ((unsigned*)(ws + WS_BAR))[i] = 0u;
    for (int t = bx; t < 256; t += G) s5_tables(P, t >> 2, t & 3, lds);
    {   THREAD_IDS
        if (bx == G - 1) for (int idx = tid; idx < 2048; idx += 512) {
            const int pos = idx >> 4, i = idx & 15; const float fr = powf(10000.0f, -(float)i / 16.0f); const float an = (float)pos * fr;
            ((float*)(ws + WS_ROPEC))[idx] = cosf(an); ((float*)(ws + WS_ROPES))[idx] = sinf(an);
        }
        for (int t = gw; t < 2 * 768; t += NGW) { const int l = t / 768, n4 = t % 768;
            gemv9_task<0>(P, P.w_mod + (size_t)l * DM * 3072, 3072, 4 * n4, nullptr, MOD + l * 9 * 3072, 3072, 4 * n4, P.b_mod + l * 3072, lane); }
        for (int it = gw; it < 1024 + 1280 + 3 * 512; it += NGW) {
            if (it < 1024) tr_plain_item<false>(P.ssm_w_in, 2048, (h16*)(ws + WS_WB0), scr, it, lane);
            else if (it < 2304) tr_plain_item<true>(P.attn_w_in, 2560, (h16*)(ws + WS_WB1), scr, it - 1024, lane);
            else { const int w = (it - 2304) / 512, r = (it - 2304) % 512;
                const float* src = w == 0 ? P.w_glu : (w == 1 ? P.ssm_w_out : P.attn_w_out); h16* dst = (h16*)(ws + (w == 0 ? WS_WGLU : (w == 1 ? WS_WOUT0 : WS_WOUT1)));
                tr_plain_item<false>(src, 1024, dst, scr, r, lane); }
        }
    }
    grid.sync();
    (void)xcd_barrier_post((unsigned*)(ws + WS_BAR), bst);
#define GRID_BAR() do { XcdBarrier xb_; xb_.bar = (unsigned*)(P.ws + WS_BAR); xb_.x = xb_xcc_id(); xb_.st = (volatile LAS unsigned*)(lds + LDS_BYTES - 64); xcd_barrier(xb_); } while (0)
    {   THREAD_IDS
        h16* XN = (h16*)(ws + WS_BUFA);
        for (int m = gw; m < MTOT; m += NGW) { const float* xr = m < NTOK ? P.x + (size_t)m * DM : P.ctx + (size_t)(m - NTOK) * DM;
            norm_row_h16(xr, P.norm_g, MOD + (m < NTOK ? (m >> 13) : 8) * 3072, XN + (size_t)m * DM, lane); }
        for (int t = gw; t < 640; t += NGW) { const int np = 4 * t; gemv9_task<1>(P, P.attn_w_in, 2560, attn_srccol(np), MOD + 9 * 3072, (float*)(ws + WS_BIAS1), 2560, np, nullptr, lane); }
        for (int i = bx * 512 + tid; i < 9 * 1024; i += G * 512) { const int bs = i >> 10, k = i & 1023; ((float*)(ws + WS_BIAS0))[i] = P.norm_g[DM + k] * (1.0f + MOD[9 * 3072 + bs * 3072 + 1024 + k]); }
    }
    GRID_BAR();
    {
        pg8::Gemm g{(const h16*)(ws + WS_BUFA), (const h16*)(ws + WS_WB0), 1024, 1024, 1024};
        pg8::SchedPlain S; S.init(MTOT, 2048, G, bx, 1024, 1024, 0);
        EpiSsmIn E{(h16*)(ws + WS_UH), (h16*)(ws + WS_BUFZ)};
        pg8::gemm_phase(lds, g, S, E);
    }
    GRID_BAR();
    {
        pg8::Gemm g{(const h16*)(ws + WS_UH), (const h16*)(ws + WS_W1S), UHW, 512, 512};
        pg8::SchedGrouped S; S.init(NCHP, 256, 64, G, bx, UHW, 512, (size_t)NCHP * UHW, (size_t)256 * 512);
        EpiS5State E{(float*)(ws + WS_X1)};
        pg8::gemm_phase(lds, g, S, E);
    }
    GRID_BAR();
    scan_phase(P);
    GRID_BAR();
    {
        pg8::Gemm g{(const h16*)(ws + WS_UH), (const h16*)(ws + WS_W2S), UHW, 768, 768};
        pg8::SchedGrouped S; S.init(NCHP, 512, 64, G, bx, UHW, 768, (size_t)NCHP * UHW, (size_t)512 * 768);
        EpiS5Out E{(h16*)(ws + WS_BUFA)};
        pg8::gemm_phase(lds, g, S, E);
    }
    GRID_BAR();
    {
        pg8::Gemm g{(const h16*)(ws + WS_BUFA), (const h16*)(ws + WS_WGLU), 1024, 1024, 1024};
        pg8::SchedPlain S; S.init(MTOT, 1024, G, bx, 1024, 1024, 0);
        EpiGlu E{(const h16*)(ws + WS_BUFA), (const h16*)(ws + WS_BUFZ), P.b_glu, (h16*)(ws + WS_UH)};
        pg8::gemm_phase(lds, g, S, E);
    }
    GRID_BAR();
    {
        pg8::Gemm g{(const h16*)(ws + WS_UH), (const h16*)(ws + WS_WOUT0), 1024, 1024, 1024};
        pg8::SchedPlain S; S.init(MTOT, 1024, G, bx, 1024, 1024, 0);
        EpiOut<false> E{P.x, P.ctx, nullptr, MOD + 2048, (h16*)(ws + WS_X1), (h16*)(ws + WS_BUFA), (const float*)(ws + WS_BIAS0), (float*)(ws + WS_SSQ1)};
        pg8::gemm_phase(lds, g, S, E);
    }
    GRID_BAR();
    {
        pg8::Gemm g{(const h16*)(ws + WS_BUFA), (const h16*)(ws + WS_WB1), 1024, 1024, 1024};
        pg8::SchedPlain S; S.init(MTOT, 2560, G, bx, 1024, 1024, 0);
        EpiAttnIn E{(const float*)(ws + WS_SSQ1), (const float*)(ws + WS_BIAS1), P.q_norm, P.k_norm, (const float*)(ws + WS_ROPEC), (const float*)(ws + WS_ROPES),
                    (h16*)(ws + WS_UH), (h16*)(ws + WS_K), (h16*)(ws + WS_VT), (h16*)(ws + WS_BUFZ)};
        pg8::gemm_phase(lds, g, S, E);
    }
    GRID_BAR();
    attn_phase(P, lds);
    GRID_BAR();
    {
        pg8::Gemm g{(const h16*)(ws + WS_BUFA), (const h16*)(ws + WS_WOUT1), 1024, 1024, 1024};
        pg8::SchedPlain S; S.init(NTOK, 1024, G, bx, 1024, 1024, 0);
        EpiOut<true> E{nullptr, nullptr, (const h16*)(ws + WS_X1), MOD + 9 * 3072 + 2048, (h16*)(ws + WS_UH), nullptr, nullptr, (float*)(ws + WS_SSQ2)};
        pg8::gemm_phase(lds, g, S, E);
    }
    GRID_BAR();
    {   THREAD_IDS
        const float* __restrict__ ssq = (const float*)(ws + WS_SSQ2);
        const h16* __restrict__ X2 = (const h16*)(ws + WS_UH);
        float* __restrict__ outp = P.out;
        f32x4 gg[4];
#pragma unroll
        for (int j = 0; j < 4; ++j) gg[j] = ((const f32x4*)P.final_g)[lane + 64 * j];
        for (int m = gw; m < NTOK; m += NGW) {
            const f32x4 s0 = *(const f32x4*)(ssq + (size_t)m * 16), s1 = *(const f32x4*)(ssq + (size_t)m * 16 + 4), s2 = *(const f32x4*)(ssq + (size_t)m * 16 + 8), s3 = *(const f32x4*)(ssq + (size_t)m * 16 + 12);
            const h16x4* xi = (const h16x4*)(X2 + (size_t)m * DM) + lane;
            f32x4 v[4];
#pragma unroll
            for (int j = 0; j < 4; ++j) { const h16x4 w = xi[64 * j]; v[j] = (f32x4){(float)w[0], (float)w[1], (float)w[2], (float)w[3]}; }
            const f32x4 st = (s0 + s1) + (s2 + s3);
            const float rstd = 1.0f / sqrtf(((st[0] + st[1]) + (st[2] + st[3])) * (1.0f / DM) + EPS);
            f32x4* o = (f32x4*)(outp + (size_t)m * DM) + lane;
#pragma unroll
            for (int j = 0; j < 4; ++j) o[64 * j] = v[j] * rstd * gg[j];
        }
    }
}

extern "C" void kernel_launch(void* const* d_in, const int* in_sizes, int n_in, void* d_out, int out_size, void* d_ws, size_t ws_size, hipStream_t stream) {
    static int grid_blocks = 0;
    if (grid_blocks == 0) {
        if (n_in != 24 || ws_size < WS_END) { fprintf(stderr, "kernel_launch: unexpected inputs (n_in %d, ws %zu)\n", n_in, ws_size); grid_blocks = -1; return; }
        int dev = 0, cus = 0, per_cu = 0;
        hipGetDevice(&dev);
        hipDeviceGetAttribute(&cus, hipDeviceAttributeMultiprocessorCount, dev);
        hipFuncSetAttribute((const void*)fwd_megakernel, hipFuncAttributeMaxDynamicSharedMemorySize, LDS_BYTES);
        hipOccupancyMaxActiveBlocksPerMultiprocessor(&per_cu, (const void*)fwd_megakernel, 512, LDS_BYTES);
        if (per_cu < 1) per_cu = 1;
        grid_blocks = cus * per_cu;
        (void)hipGetLastError();
    }
    if (grid_blocks < 0) return;
    Params p{};
    const float** pp = (const float**)&p;
    for (int i = 0; i < 24; ++i) pp[i] = (const float*)d_in[i];
    p.out = (float*)d_out; p.ws = (unsigned char*)d_ws;
    void* args[] = {&p};
    hipError_t e = hipLaunchCooperativeKernel((const void*)fwd_megakernel, dim3(grid_blocks), dim3(512), args, LDS_BYTES, stream);
    if (e != hipSuccess) fprintf(stderr, "cooperative launch failed: %s (grid %d)\n", hipGetErrorString(e), grid_blocks);
}
```

```cpp
#include <hip/hip_runtime.h>
#include <hip/hip_cooperative_groups.h>
#include <cstdio>
#include <cstdint>
namespace cg = cooperative_groups;

#define LAS __attribute__((address_space(3)))
typedef _Float16 h16;
typedef _Float16 h16x8 __attribute__((ext_vector_type(8)));
typedef _Float16 h16x2 __attribute__((ext_vector_type(2)));
typedef _Float16 h16x4 __attribute__((ext_vector_type(4)));
typedef float f32x4 __attribute__((ext_vector_type(4)));
typedef float f32x2 __attribute__((ext_vector_type(2)));
typedef float f32x16 __attribute__((ext_vector_type(16)));
typedef unsigned u32x4 __attribute__((ext_vector_type(4)));
typedef unsigned u32x2 __attribute__((ext_vector_type(2)));

constexpr int DM = 1024, NB = 8, SEQ = 8192, CTXL = 256;
constexpr int NTOK = NB * SEQ;
constexpr int NCTX = NB * CTXL;
constexpr int MTOT = NTOK + NCTX;
constexpr int TCH = 32;
constexpr int NCH = MTOT / TCH;
constexpr int NCHP = 2304;
constexpr int UHW = 768;
constexpr int KVL = SEQ + CTXL;
constexpr int NKT = KVL / 64;
constexpr float EPS = 1e-6f;
constexpr float LOG2E = 1.4426950408889634f;
constexpr float QSCALE = 0.125f * LOG2E;

constexpr size_t MiB = 1u << 20;
constexpr size_t WS_MOD = 0;
constexpr size_t WS_BIAS0 = 1 * MiB;
constexpr size_t WS_BIAS1 = 1 * MiB + 512 * 1024;
constexpr size_t WS_ROPEC = 2 * MiB;
constexpr size_t WS_ROPES = 3 * MiB;
constexpr size_t WS_SSQ1 = 4 * MiB;
constexpr size_t WS_SSQ2 = 9 * MiB;
constexpr size_t WS_WGLU = 16 * MiB;
constexpr size_t WS_WOUT0 = 18 * MiB;
constexpr size_t WS_WOUT1 = 20 * MiB;
constexpr size_t WS_W1S = 22 * MiB;
constexpr size_t WS_W2S = 38 * MiB;
constexpr size_t WS_WB0 = 86 * MiB;
constexpr size_t WS_WB1 = 122 * MiB;
constexpr size_t WS_K = 168 * MiB;
constexpr size_t WS_VT = 202 * MiB;
constexpr size_t WS_BUFA = 236 * MiB;
constexpr size_t WS_BUFZ = 368 * MiB;
constexpr size_t WS_UH = 500 * MiB;
constexpr size_t WS_X1 = 716 * MiB;
constexpr size_t WS_END = 980 * MiB;
static_assert(WS_W2S + (size_t)64 * 512 * 768 * 2 <= WS_WB0 && WS_WB0 + (size_t)9 * 2048 * 1024 * 2 <= WS_WB1 && WS_WB1 + (size_t)9 * 2560 * 1024 * 2 <= WS_K, "ws map 1");
static_assert(WS_K + (size_t)32 * KVL * 64 * 2 <= WS_VT && WS_VT + (size_t)32 * KVL * 64 * 2 <= WS_BUFA && WS_BUFA + (size_t)MTOT * DM * 2 <= WS_BUFZ, "ws map 2");
static_assert(WS_BUFZ + (size_t)MTOT * DM * 2 <= WS_UH && WS_UH + (size_t)64 * NCHP * UHW * 2 <= WS_X1 && WS_X1 + (size_t)MTOT * DM * 4 <= WS_END, "ws map 3");
static_assert((size_t)64 * NCHP * 256 * 4 <= (size_t)MTOT * DM * 4, "S fits in X1 region");

constexpr int LDS_BYTES = 147456;

struct Params {
    const float *x, *c, *ctx, *c_ctx, *w_mod, *b_mod, *norm_g, *ssm_w_in, *a_re, *a_im, *log_dt, *b_re, *b_im, *c_re, *c_im, *ssm_d,
        *w_glu, *b_glu, *ssm_w_out, *attn_w_in, *q_norm, *k_norm, *attn_w_out, *final_g;
    float* out;
    unsigned char* ws;
};

__device__ __forceinline__ unsigned pk2(float lo, float hi) { f32x2 v = {lo, hi}; h16x2 h = __builtin_convertvector(v, h16x2); return __builtin_bit_cast(unsigned, h); }
__device__ __forceinline__ u32x4 pk8(f32x4 a, f32x4 b) { u32x4 w; w.x = pk2(a[0], a[1]); w.y = pk2(a[2], a[3]); w.z = pk2(b[0], b[1]); w.w = pk2(b[2], b[3]); return w; }
__device__ __forceinline__ float silu_f(float v) { return v * __builtin_amdgcn_rcpf(1.0f + __expf(-v)); }
__device__ __forceinline__ float sigm_f(float v) { return __builtin_amdgcn_rcpf(1.0f + __expf(-v)); }
__device__ __forceinline__ float wave_sum(float v) {
#pragma unroll
    for (int o = 1; o < 64; o <<= 1) v += __shfl_xor(v, o);
    return v;
}
__device__ __forceinline__ float wave_max(float v) {
#pragma unroll
    for (int o = 1; o < 64; o <<= 1) v = fmaxf(v, __shfl_xor(v, o));
    return v;
}
__device__ __forceinline__ void unpack8(const h16* p, float* f) {
    const h16x8 v = *(const h16x8*)p;
#pragma unroll
    for (int i = 0; i < 8; ++i) f[i] = (float)v[i];
}
__device__ __forceinline__ f32x2 gelu_pk(f32x2 v) {
    const f32x2 av = __builtin_elementwise_abs(v), d = av * 0.2316418882f + 1.0f;
    f32x2 t; t.x = __builtin_amdgcn_rcpf(d.x); t.y = __builtin_amdgcn_rcpf(d.y);
    f32x2 q = t * 0.5307027145f + (-0.7265760135f); q = q * t + 0.7107068705f; q = q * t + (-0.142248368f); q = q * t + 0.127414796f; q = q * t;
    const f32x2 s = (v * v) * (-0.72134752044f);
    f32x2 e; e.x = __builtin_amdgcn_exp2f(s.x); e.y = __builtin_amdgcn_exp2f(s.y);
    const f32x2 m = v * (q * e), r = v - m;
    f32x2 o; o.x = v.x < 0.f ? m.x : r.x; o.y = v.y < 0.f ? m.y : r.y; return o;
}
__device__ __forceinline__ int bsel_of_pm(int pm) { return pm < 256 ? (pm >> 5) : 8; }

namespace pg8 {
constexpr int BM = 256, BK = 64, HALF = 128, HTB = HALF * BK * 2, STAGE_BYTES = 8 * HTB, NXCD = 8, WGM = 8;
__device__ __forceinline__ int lds_byte(int r, int c) { const int st = (r >> 4) * 2 + (c >> 5), rr = r & 15, cc = c & 31, ob = rr * 64 + cc * 2; return st * 1024 + (ob ^ (((ob >> 9) & 1) << 5)); }
__device__ __forceinline__ void stage_rc(int b, int& R, int& C) { const int st = b / 1024, sb = b % 1024, swz = sb ^ (((sb >> 9) & 1) << 5); R = (st >> 1) * 16 + swz / 64; C = (st & 1) * 32 + (swz % 64) / 2; }
__device__ __forceinline__ int perm32(int rho) { const int n = rho >> 4, i = rho & 15; return 8 * (i >> 2) + 4 * n + (i & 3); }

struct Unit { int pm, pn, z; };
struct Gemm { const h16* A; const h16* Bt; int lda, ldb, K; };

struct SchedPlain {
    int nM, nN, nwg, G, c, lda, ldb; size_t bsel_stride;
    int wgm;
    __device__ void init(int M, int N, int G_, int c_, int lda_, int ldb_, size_t bs) { nM = M / BM; nN = N / BM; nwg = nM * nN; G = G_; c = c_; lda = lda_; ldb = ldb_; bsel_stride = bs; wgm = 32 / nN; if (wgm < 1) wgm = 1; }
    __device__ __forceinline__ bool next(int i, Unit& u) const {
        const long L = (long)i * G + c; if (L >= nwg) return false;
        int wgid = (int)L; { const int q = nwg / NXCD, r = nwg % NXCD, xcd = wgid % NXCD, off = wgid / NXCD; wgid = (xcd < r ? xcd * (q + 1) : r * (q + 1) + (xcd - r) * q) + off; }
        const int nig = wgm * nN, gid = wgid / nig, fm = gid * wgm, gsz = (nM - fm) < wgm ? (nM - fm) : wgm;
        u.pm = fm + ((wgid % nig) % gsz); u.pn = (wgid % nig) / gsz; u.z = 0; return true;
    }
    __device__ __forceinline__ size_t a_off(const Unit& u) const { return (size_t)u.pm * BM * lda; }
    __device__ __forceinline__ size_t b_off(const Unit& u) const { return (bsel_stride ? (size_t)bsel_of_pm(u.pm) * bsel_stride : 0) + (size_t)u.pn * BM * ldb; }
};
struct SchedGrouped {
    int nM, nN, nz, G, c, lda, ldb; size_t a_gs, b_gs;
    __device__ void init(int M, int N, int nz_, int G_, int c_, int lda_, int ldb_, size_t ags, size_t bgs) { nM = M / BM; nN = N / BM; nz = nz_; G = G_; c = c_; lda = lda_; ldb = ldb_; a_gs = ags; b_gs = bgs; }
    __device__ __forceinline__ bool next(int i, Unit& u) const {
        const long L = (long)i * G + c; const int per = nM * nN; const long tot = (long)nz * per; if (L >= tot) return false;
        int w = (int)L; if (tot % NXCD == 0) { const int q = (int)(tot / NXCD); w = (w % NXCD) * q + w / NXCD; }
        u.z = w / per; const int t = w % per; u.pm = t / nN; u.pn = t % nN; return true;
    }
    __device__ __forceinline__ size_t a_off(const Unit& u) const { return (size_t)u.z * a_gs + (size_t)u.pm * BM * lda; }
    __device__ __forceinline__ size_t b_off(const Unit& u) const { return (size_t)u.z * b_gs + (size_t)u.pn * BM * ldb; }
};

template <class Epi, class Sched>
__device__ __forceinline__ void gemm_phase(LAS unsigned char* lds, const Gemm g, const Sched& S, const Epi& E) {
    int tid = threadIdx.x; asm volatile("" : "+v"(tid));
    const int wid = __builtin_amdgcn_readfirstlane(tid >> 6), lane = tid & 63, wr = wid >> 2, wc = wid & 3, fr = lane & 15, fq = lane >> 4;
    const int K = g.K, nt = K / BK;
    unsigned voffA[2], voffB[2];
#pragma unroll
    for (int i = 0; i < 2; ++i) { int R, C; stage_rc(tid * 16 + i * 8192, R, C); const int Rb = (R & ~31) + perm32(R & 31);
        voffA[i] = (unsigned)(R * g.lda + C) * 2u; voffB[i] = (unsigned)(Rb * g.ldb + C) * 2u; }
    const size_t kstep = (size_t)(BK * 2);
    const size_t hsA = (size_t)HALF * g.lda * 2, hsB = (size_t)HALF * g.ldb * 2;
    const unsigned ldsw = (unsigned)wid * 1024u;
    const int aoff = lds_byte(wr * 64 + fr, fq * 8), boff = lds_byte(wc * 32 + fr, fq * 8);
#define PG8_SA(b, h) (((b) * 2 + (h)) * HTB)
#define PG8_SB(b, h) ((4 + (b) * 2 + (h)) * HTB)
#define PG8_STAGE(bufoff, gbase, voff) do { _Pragma("unroll") for (int _i = 0; _i < 2; ++_i) \
        __builtin_amdgcn_global_load_lds((const unsigned*)((const char*)(gbase) + (voff)[_i]), (LAS unsigned*)(lds + (bufoff) + ldsw + _i * 8192), 16, 0, 0); } while (0)
#define PG8_LDA(dst, b, h) do { _Pragma("unroll") for (int m = 0; m < 4; ++m) _Pragma("unroll") for (int k = 0; k < 2; ++k) dst[m][k] = *(const LAS h16x8*)(lds + PG8_SA(b, h) + aoff + m * 2048 + k * 1024); } while (0)
#define PG8_LDB(dst, b, h) do { _Pragma("unroll") for (int n = 0; n < 2; ++n) _Pragma("unroll") for (int k = 0; k < 2; ++k) dst[n][k] = *(const LAS h16x8*)(lds + PG8_SB(b, h) + boff + n * 2048 + k * 1024); } while (0)
#define PG8_MMA(ai, bj, At, Bt) do { __builtin_amdgcn_s_setprio(1); _Pragma("unroll") for (int m = 0; m < 4; ++m) _Pragma("unroll") for (int n = 0; n < 2; ++n) _Pragma("unroll") for (int k = 0; k < 2; ++k) \
        acc[ai][bj][m][n] = __builtin_amdgcn_mfma_f32_16x16x32_f16(Bt[n][k], At[m][k], acc[ai][bj][m][n], 0, 0, 0); __builtin_amdgcn_s_setprio(0); } while (0)
#define PG8_WAIT_V(n) asm volatile("s_waitcnt vmcnt(" #n ")" ::: "memory")
#define PG8_WAIT_L(n) asm volatile("s_waitcnt lgkmcnt(" #n ")" ::: "memory")
#define PG8_BAR __builtin_amdgcn_s_barrier()
#define PG8_SCHED __builtin_amdgcn_sched_barrier(0)
    Unit cur, nxt; int ui = 0;
    if (!S.next(0, cur)) return;
    f32x4 acc[2][2][4][2];
#pragma unroll
    for (int a = 0; a < 2; ++a)
#pragma unroll
        for (int b = 0; b < 2; ++b)
#pragma unroll
            for (int m = 0; m < 4; ++m)
#pragma unroll
                for (int n = 0; n < 2; ++n) acc[a][b][m][n] = (f32x4){0.f, 0.f, 0.f, 0.f};
    h16x8 At[4][2], B0[2][2], B1[2][2];
    const char* cA = (const char*)g.A + S.a_off(cur) * 2; const char* cB = (const char*)g.Bt + S.b_off(cur) * 2;
    PG8_STAGE(PG8_SB(0, 0), cB, voffB); PG8_STAGE(PG8_SB(0, 1), cB + hsB, voffB); PG8_STAGE(PG8_SA(0, 0), cA, voffA); PG8_STAGE(PG8_SA(0, 1), cA + hsA, voffA);
    if (wr == 1) PG8_BAR;
    PG8_WAIT_V(2); PG8_BAR;
    PG8_STAGE(PG8_SB(1, 0), cB + kstep, voffB); PG8_STAGE(PG8_SA(1, 0), cA + kstep, voffA); PG8_STAGE(PG8_SB(1, 1), cB + hsB + kstep, voffB);
    PG8_WAIT_V(6); PG8_BAR;
    for (;;) {
        const bool has_next = S.next(ui + 1, nxt);
        const char* nA = has_next ? (const char*)g.A + S.a_off(nxt) * 2 : cA; const char* nB = has_next ? (const char*)g.Bt + S.b_off(nxt) * 2 : cB;
        for (int t = 0; t < nt; t += 2) {
            const bool last = (t == nt - 2);
            const char* a1 = cA + (size_t)(t + 1) * kstep;
            const char* a2 = last ? nA : cA + (size_t)(t + 2) * kstep; const char* b2 = last ? nB : cB + (size_t)(t + 2) * kstep;
            const char* a3 = a2 + kstep; const char* b3 = b2 + kstep;
            PG8_LDB(B0, 0, 0); PG8_LDB(B1, 0, 1); PG8_SCHED; PG8_LDA(At, 0, 0); PG8_STAGE(PG8_SA(1, 1), a1 + hsA, voffA);
            PG8_WAIT_V(8); PG8_WAIT_L(0); PG8_BAR; PG8_MMA(0, 0, At, B0); PG8_MMA(0, 1, At, B1); PG8_BAR; PG8_SCHED;
            PG8_LDA(At, 0, 1); PG8_STAGE(PG8_SB(0, 0), b2, voffB); PG8_STAGE(PG8_SB(0, 1), b2 + hsB, voffB); PG8_STAGE(PG8_SA(0, 0), a2, voffA);
            PG8_WAIT_V(8); PG8_WAIT_L(0); PG8_BAR; PG8_MMA(1, 0, At, B0); PG8_MMA(1, 1, At, B1); PG8_BAR; PG8_SCHED;
            PG8_LDB(B0, 1, 0); PG8_LDB(B1, 1, 1); PG8_SCHED; PG8_LDA(At, 1, 0); PG8_STAGE(PG8_SA(0, 1), a2 + hsA, voffA);
            PG8_WAIT_V(8); PG8_WAIT_L(0); PG8_BAR; PG8_MMA(0, 0, At, B0); PG8_MMA(0, 1, At, B1); PG8_BAR; PG8_SCHED;
            PG8_LDA(At, 1, 1); PG8_STAGE(PG8_SB(1, 0), b3, voffB); PG8_STAGE(PG8_SB(1, 1), b3 + hsB, voffB); PG8_STAGE(PG8_SA(1, 0), a3, voffA);
            PG8_WAIT_V(8); PG8_WAIT_L(0); PG8_BAR; PG8_MMA(1, 0, At, B0); PG8_MMA(1, 1, At, B1); PG8_BAR; PG8_SCHED;
        }
        if (wr == 0) PG8_BAR;
        E(acc, cur, wr, wc, fr, fq);
        if (!has_next) break;
#pragma unroll
        for (int a = 0; a < 2; ++a)
#pragma unroll
            for (int b = 0; b < 2; ++b)
#pragma unroll
                for (int m = 0; m < 4; ++m)
#pragma unroll
                    for (int n = 0; n < 2; ++n) acc[a][b][m][n] = (f32x4){0.f, 0.f, 0.f, 0.f};
        cur = nxt; cA = nA; cB = nB; ++ui;
        if (wr == 1) PG8_BAR;
    }
    PG8_WAIT_V(0);
    PG8_BAR;
#undef PG8_SA
#undef PG8_SB
#undef PG8_STAGE
#undef PG8_LDA
#undef PG8_LDB
#undef PG8_MMA
#undef PG8_WAIT_V
#undef PG8_WAIT_L
#undef PG8_BAR
#undef PG8_SCHED
}
}

typedef f32x4 AccT[2][2][4][2];

struct EpiSsmIn {
    h16* UH; h16* Z;
    __device__ __forceinline__ void operator()(const AccT& acc, const pg8::Unit& u, int wr, int wc, int fr, int fq) const {
        const int cw = wc * 32 + 8 * fq;
#pragma unroll
        for (int ai = 0; ai < 2; ++ai)
#pragma unroll
            for (int m = 0; m < 4; ++m) {
                const int row = u.pm * 256 + ai * 128 + wr * 64 + m * 16 + fr;
#pragma unroll
                for (int bj = 0; bj < 2; ++bj) {
                    f32x4 v0 = acc[ai][bj][m][0], v1 = acc[ai][bj][m][1];
                    const int col = u.pn * 256 + bj * 128 + cw;
                    if (u.pn < 4) {
                        const int g = col >> 4, h0 = col & 15, cr = row >> 5, s = row & 31;
                        *(u32x4*)(UH + ((size_t)(g * NCHP + cr) * UHW + s * 16 + h0)) = pk8(v0, v1);
                    } else {
#pragma unroll
                        for (int e = 0; e < 4; ++e) { v0[e] = silu_f(v0[e]); v1[e] = silu_f(v1[e]); }
                        *(u32x4*)(Z + ((size_t)row * DM + (col - 1024))) = pk8(v0, v1);
                    }
                }
            }
    }
};
struct EpiS5State {
    float* S;
    __device__ __forceinline__ void operator()(const AccT& acc, const pg8::Unit& u, int wr, int wc, int fr, int fq) const {
#pragma unroll
        for (int ai = 0; ai < 2; ++ai)
#pragma unroll
            for (int m = 0; m < 4; ++m) {
                const int row = u.pm * 256 + ai * 128 + wr * 64 + m * 16 + fr;
                float* rp = S + ((size_t)(u.z * NCHP + row) * 256 + wc * 32 + 8 * fq);
#pragma unroll
                for (int bj = 0; bj < 2; ++bj) { *(f32x4*)(rp + bj * 128) = acc[ai][bj][m][0]; *(f32x4*)(rp + bj * 128 + 4) = acc[ai][bj][m][1]; }
            }
    }
};
struct EpiS5Out {
    h16* Y1;
    __device__ __forceinline__ void operator()(const AccT& acc, const pg8::Unit& u, int wr, int wc, int fr, int fq) const {
#pragma unroll
        for (int ai = 0; ai < 2; ++ai)
#pragma unroll
            for (int m = 0; m < 4; ++m) {
                const int cr = u.pm * 256 + ai * 128 + wr * 64 + m * 16 + fr;
                if (cr < NCH) {
#pragma unroll
                    for (int bj = 0; bj < 2; ++bj) {
                        const int n = u.pn * 256 + bj * 128 + wc * 32 + 8 * fq; const int s = n >> 4, h0 = n & 15;
                        const f32x4 a = acc[ai][bj][m][0], b = acc[ai][bj][m][1];
                        const f32x2 g0 = gelu_pk((f32x2){a[0], a[1]}), g1 = gelu_pk((f32x2){a[2], a[3]}), g2 = gelu_pk((f32x2){b[0], b[1]}), g3 = gelu_pk((f32x2){b[2], b[3]});
                        u32x4 w; w.x = pk2(g0.x, g0.y); w.y = pk2(g1.x, g1.y); w.z = pk2(g2.x, g2.y); w.w = pk2(g3.x, g3.y);
                        *(u32x4*)(Y1 + ((size_t)(cr * TCH + s) * DM + u.z * 16 + h0)) = w;
                    }
                }
            }
    }
};
struct EpiGlu {
    const h16* Y1; const h16* Z; const float* bglu; h16* G2;
    __device__ __forceinline__ void operator()(const AccT& acc, const pg8::Unit& u, int wr, int wc, int fr, int fq) const {
        const int cw = u.pn * 256 + wc * 32 + 8 * fq;
        f32x4 bv[2][2];
#pragma unroll
        for (int bj = 0; bj < 2; ++bj)
#pragma unroll
            for (int n = 0; n < 2; ++n) bv[bj][n] = *(const f32x4*)(bglu + cw + bj * 128 + 4 * n);
#pragma unroll
        for (int ai = 0; ai < 2; ++ai)
#pragma unroll
            for (int m = 0; m < 4; ++m) {
                const int row = u.pm * 256 + ai * 128 + wr * 64 + m * 16 + fr;
#pragma unroll
                for (int bj = 0; bj < 2; ++bj) {
                    const size_t off = (size_t)row * DM + cw + bj * 128;
                    float y[8], z[8]; unpack8(Y1 + off, y); unpack8(Z + off, z);
                    f32x4 v0 = acc[ai][bj][m][0] + bv[bj][0], v1 = acc[ai][bj][m][1] + bv[bj][1];
#pragma unroll
                    for (int e = 0; e < 4; ++e) { v0[e] = y[e] * sigm_f(v0[e]) * z[e]; v1[e] = y[4 + e] * sigm_f(v1[e]) * z[4 + e]; }
                    *(u32x4*)(G2 + off) = pk8(v0, v1);
                }
            }
    }
};
template <bool IN16>
struct EpiOut {
    const float* xin; const float* xin_ctx; const h16* xin16; const float* gate;   h16* xout16; h16* xh; const float* xhf;   float* ssq;
    __device__ __forceinline__ void operator()(const AccT& acc, const pg8::Unit& u, int wr, int wc, int fr, int fq) const {
        const int bs = bsel_of_pm(u.pm); const int cw = u.pn * 256 + wc * 32 + 8 * fq;
        const float* gp = gate + bs * 3072 + cw;
#pragma unroll
        for (int ai = 0; ai < 2; ++ai)
#pragma unroll
            for (int m = 0; m < 4; ++m) {
                const int row = u.pm * 256 + ai * 128 + wr * 64 + m * 16 + fr;
                float sq = 0.f;
#pragma unroll
                for (int bj = 0; bj < 2; ++bj) {
                    const int col = cw + bj * 128;
                    const f32x4 g0 = *(const f32x4*)(gp + bj * 128), g1 = *(const f32x4*)(gp + bj * 128 + 4);
                    f32x4 x0, x1;
                    if (IN16) { float xv[8]; unpack8(xin16 + (size_t)row * DM + col, xv); x0 = (f32x4){xv[0], xv[1], xv[2], xv[3]}; x1 = (f32x4){xv[4], xv[5], xv[6], xv[7]}; }
                    else { const float* xr = (row < NTOK) ? xin + (size_t)row * DM : xin_ctx + (size_t)(row - NTOK) * DM; x0 = *(const f32x4*)(xr + col); x1 = *(const f32x4*)(xr + col + 4); }
                    const f32x4 o0 = x0 + g0 * acc[ai][bj][m][0], o1 = x1 + g1 * acc[ai][bj][m][1];
                    *(u32x4*)(xout16 + (size_t)row * DM + col) = pk8(o0, o1);
                    if (xh) { const f32x4 f0 = *(const f32x4*)(xhf + bs * 1024 + col), f1 = *(const f32x4*)(xhf + bs * 1024 + col + 4); *(u32x4*)(xh + (size_t)row * DM + col) = pk8(o0 * f0, o1 * f1); }
#pragma unroll
                    for (int e = 0; e < 4; ++e) sq += o0[e] * o0[e] + o1[e] * o1[e];
                }
                sq += __shfl_xor(sq, 16); sq += __shfl_xor(sq, 32);
                if (fq == 0) ssq[(size_t)row * 16 + u.pn * 4 + wc] = sq;
            }
    }
};
struct EpiAttnIn {
    const float* ssq; const float* bias; const float* qn; const float* kn; const float* ropec; const float* ropes;
    h16* Q; h16* Kb; h16* Vt; h16* Z;
    __device__ __forceinline__ void operator()(const AccT& acc, const pg8::Unit& u, int wr, int wc, int fr, int fq) const {
        const int bs = bsel_of_pm(u.pm); const int cw = wc * 32 + 8 * fq;
        const float* bp = bias + bs * 2560 + u.pn * 256 + cw;
        const bool is_ctx = (u.pm >= 256);
        if (is_ctx && (u.pn < 4 || u.pn >= 6)) return;
        f32x4 bv[2][2];
#pragma unroll
        for (int bj = 0; bj < 2; ++bj)
#pragma unroll
            for (int n = 0; n < 2; ++n) bv[bj][n] = *(const f32x4*)(bp + bj * 128 + 4 * n);
        if (u.pn < 5) {
            const float* nwp = (u.pn < 4) ? qn : kn;
            const int dlo = 32 * (fq >> 1) + 8 * (fq & 1);
            f32x4 nw[2][2];
#pragma unroll
            for (int bj = 0; bj < 2; ++bj)
#pragma unroll
                for (int n = 0; n < 2; ++n) nw[bj][n] = *(const f32x4*)(nwp + dlo + 16 * bj + 4 * n);
            const float osc = (u.pn < 4) ? QSCALE : 1.0f;
#pragma unroll
            for (int ai = 0; ai < 2; ++ai)
#pragma unroll
                for (int m = 0; m < 4; ++m) {
                    const int row = u.pm * 256 + ai * 128 + wr * 64 + m * 16 + fr;
                    const f32x4 s0 = *(const f32x4*)(ssq + (size_t)row * 16), s1 = *(const f32x4*)(ssq + (size_t)row * 16 + 4), s2 = *(const f32x4*)(ssq + (size_t)row * 16 + 8), s3 = *(const f32x4*)(ssq + (size_t)row * 16 + 12);
                    const f32x4 st = (s0 + s1) + (s2 + s3);
                    const float rstd = __builtin_amdgcn_rsqf(((st[0] + st[1]) + (st[2] + st[3])) * (1.0f / 1024.0f) + EPS);
                    f32x4 v[2][2]; float sq = 0.f;
#pragma unroll
                    for (int bj = 0; bj < 2; ++bj)
#pragma unroll
                        for (int n = 0; n < 2; ++n) { v[bj][n] = acc[ai][bj][m][n] * rstd + bv[bj][n];
#pragma unroll
                            for (int e = 0; e < 4; ++e) sq += v[bj][n][e] * v[bj][n][e]; }
                    sq += __shfl_xor(sq, 16); sq += __shfl_xor(sq, 32);
                    const float rn = __builtin_amdgcn_rsqf(sq * (1.0f / 64.0f) + EPS) ;
                    f32x4 o[2][2];
                    if (!is_ctx) {
                        const int t = row & (SEQ - 1); const int pos = (fq >> 1) ? (t & 63) : (t >> 6);
                        const float* cp = ropec + pos * 16 + 8 * (fq & 1); const float* sp = ropes + pos * 16 + 8 * (fq & 1);
#pragma unroll
                        for (int n = 0; n < 2; ++n) {
                            const f32x4 cs = *(const f32x4*)(cp + 4 * n), sn = *(const f32x4*)(sp + 4 * n);
                            const f32x4 x1 = v[0][n] * rn * nw[0][n], x2 = v[1][n] * rn * nw[1][n];
                            o[0][n] = (x1 * cs - x2 * sn) * osc; o[1][n] = (x2 * cs + x1 * sn) * osc;
                        }
                    } else {
#pragma unroll
                        for (int n = 0; n < 2; ++n) { o[0][n] = v[0][n] * rn * nw[0][n]; o[1][n] = v[1][n] * rn * nw[1][n]; }
                    }
                    if (u.pn < 4) {
                        h16* qp = Q + (size_t)row * DM + (4 * u.pn + wc) * 64 + dlo;
                        *(u32x4*)(qp) = pk8(o[0][0], o[0][1]); *(u32x4*)(qp + 16) = pk8(o[1][0], o[1][1]);
                    } else {
                        int b, key; if (!is_ctx) { b = row >> 13; key = row & (SEQ - 1); } else { const int rc = row - NTOK; b = rc >> 8; key = SEQ + (rc & 255); }
                        h16* kp = Kb + ((size_t)((b * 4 + wc) * KVL + key)) * 64 + dlo;
                        *(u32x4*)(kp) = pk8(o[0][0], o[0][1]); *(u32x4*)(kp + 16) = pk8(o[1][0], o[1][1]);
                    }
                }
        } else {
#pragma unroll
            for (int ai = 0; ai < 2; ++ai)
#pragma unroll
                for (int m = 0; m < 4; ++m) {
                    const int row = u.pm * 256 + ai * 128 + wr * 64 + m * 16 + fr;
                    const f32x4 s0 = *(const f32x4*)(ssq + (size_t)row * 16), s1 = *(const f32x4*)(ssq + (size_t)row * 16 + 4), s2 = *(const f32x4*)(ssq + (size_t)row * 16 + 8), s3 = *(const f32x4*)(ssq + (size_t)row * 16 + 12);
                    const f32x4 st = (s0 + s1) + (s2 + s3);
                    const float rstd = __builtin_amdgcn_rsqf(((st[0] + st[1]) + (st[2] + st[3])) * (1.0f / 1024.0f) + EPS);
#pragma unroll
                    for (int bj = 0; bj < 2; ++bj) {
                        f32x4 v0 = acc[ai][bj][m][0] * rstd + bv[bj][0], v1 = acc[ai][bj][m][1] * rstd + bv[bj][1];
                        if (u.pn == 5) {
                            int b, key; if (!is_ctx) { b = row >> 13; key = row & (SEQ - 1); } else { const int rc = row - NTOK; b = rc >> 8; key = SEQ + (rc & 255); }
                            const int g = bj * 2 + (wc >> 1), d0 = (wc & 1) * 32 + 8 * fq;
                            h16* vp = Vt + ((size_t)((b * 4 + g) * 64 + d0)) * KVL + key;
#pragma unroll
                            for (int e = 0; e < 4; ++e) { vp[(size_t)e * KVL] = (h16)v0[e]; vp[(size_t)(4 + e) * KVL] = (h16)v1[e]; }
                        } else {
#pragma unroll
                            for (int e = 0; e < 4; ++e) { v0[e] = silu_f(v0[e]); v1[e] = silu_f(v1[e]); }
                            *(u32x4*)(Z + (size_t)row * DM + (u.pn - 6) * 256 + bj * 128 + cw) = pk8(v0, v1);
                        }
                    }
                }
        }
    }
};

__device__ __forceinline__ int attn_srccol(int np);
template <bool ATTN>
__device__ __forceinline__ void tr_plain_item(const float* W, int N, h16* WT, LAS float* scr, int item, int lane) {
    const int nblk = N / 32, kb = item / nblk, nb = item % nblk, k0 = 64 * kb, n0 = 32 * nb;
    const int sc = ATTN ? attn_srccol(n0 + (lane & 31)) : (n0 + (lane & 31));
#pragma unroll 8
    for (int i = 0; i < 32; ++i) { const int kk = 2 * i + (lane >> 5); scr[kk * 33 + (lane & 31)] = W[(size_t)(k0 + kk) * N + sc]; }
    const int c = lane & 7;
#pragma unroll
    for (int j = 0; j < 4; ++j) { const int n = (lane >> 3) + 8 * j; const LAS float* s = scr + (8 * c) * 33 + n;
        u32x4 o; o.x = pk2(s[0 * 33], s[1 * 33]); o.y = pk2(s[2 * 33], s[3 * 33]); o.z = pk2(s[4 * 33], s[5 * 33]); o.w = pk2(s[6 * 33], s[7 * 33]);
        *(u32x4*)(WT + (size_t)(n0 + n) * 1024 + k0 + 8 * c) = o; }
}
__device__ __forceinline__ int attn_srccol(int np) {
    if (np >= 1280) return np;
    const int pn = np >> 8, nn = np & 255, bj = nn >> 7, wc = (nn >> 5) & 3, fq = (nn >> 3) & 3, j = nn & 7;
    return pn * 256 + 64 * wc + 32 * (fq >> 1) + 16 * bj + 8 * (fq & 1) + j;
}
template <int MODE>
__device__ __forceinline__ void gemv9_task(const Params& P, const float* W, int N, int col0, const float* modl, float* out, int ostride, int ocol, const float* addv, int lane) {
    f32x4 a[9];
#pragma unroll
    for (int b = 0; b < 9; ++b) a[b] = (f32x4){0.f, 0.f, 0.f, 0.f};
    for (int j = 0; j < 16; ++j) {
        const int k = lane + 64 * j;
        const f32x4 w = *(const f32x4*)(W + (size_t)k * N + col0);
#pragma unroll
        for (int b = 0; b < 9; ++b) {
            float sv;
            if (MODE == 0) { const float cv = (b < 8) ? P.c[b * DM + k] : P.c_ctx[k]; sv = silu_f(cv); }
            else sv = modl[b * 3072 + k];
            a[b] += w * sv;
        }
    }
#pragma unroll
    for (int b = 0; b < 9; ++b) {
#pragma unroll
        for (int e = 0; e < 4; ++e) a[b][e] = wave_sum(a[b][e]);
    }
    if (lane == 0) {
#pragma unroll
        for (int b = 0; b < 9; ++b) { f32x4 r = a[b]; if (addv) r += *(const f32x4*)(addv + ocol); *(f32x4*)(out + (size_t)b * ostride + ocol) = r; }
    }
}

__device__ __forceinline__ void s5_tables(const Params& P, int g, int qt, LAS unsigned char* lds) {
    LAS f32x2* E = (LAS f32x2*)lds;
    LAS f32x2* Bb = (LAS f32x2*)(lds + 33792);
    LAS f32x2* Cc = (LAS f32x2*)(lds + 50176);
    LAS float* Kt = (LAS float*)(lds + 66816);
    const int tid = threadIdx.x;
    for (int idx = tid; idx < 2 * 64 * 33; idx += 512) {
        const int d = idx / 2112, rem = idx % 2112, p = rem / 33, k = rem % 33;
        const float dt = expf(P.log_dt[d * 64 + g]); const float ar = P.a_re[(d * 64 + g) * 64 + p], ai = P.a_im[(d * 64 + g) * 64 + p];
        const float re = ar * dt * (float)k, im = ai * dt * (float)k; const float mg = expf(re);
        E[idx] = (f32x2){mg * cosf(im), mg * sinf(im)};
    }
    for (int idx = tid; idx < 2048; idx += 512) {
        const int d = idx >> 10, p = (idx >> 4) & 63, h = idx & 15;
        const float dt = expf(P.log_dt[d * 64 + g]); const float ar = P.a_re[(d * 64 + g) * 64 + p], ai = P.a_im[(d * 64 + g) * 64 + p];
        const float zr = ar * dt, zi = ai * dt; const float er = expm1f(zr), cz = cosf(zi), sz = sinf(zi), sh = sinf(0.5f * zi);
        const float nr = er * cz - 2.0f * sh * sh, ni = (er + 1.0f) * sz;
        const float den = 1.0f / (ar * ar + ai * ai); const float qr = (nr * ar + ni * ai) * den, qi = (ni * ar - nr * ai) * den;
        const float br = P.b_re[((size_t)(d * 64 + g) * 64 + p) * 16 + h], bi = P.b_im[((size_t)(d * 64 + g) * 64 + p) * 16 + h];
        Bb[idx] = (f32x2){qr * br - qi * bi, qr * bi + qi * br};
    }
    for (int idx = tid; idx < 2048; idx += 512) {
        const int d = idx >> 10, h = (idx >> 6) & 15, p = idx & 63;
        Cc[(d * 16 + h) * 65 + p] = (f32x2){P.c_re[((size_t)(d * 64 + g) * 16 + h) * 64 + p], P.c_im[((size_t)(d * 64 + g) * 16 + h) * 64 + p]};
    }
    __syncthreads();
    for (int t = tid; t < 1024; t += 512) {
        const int d = t >> 9, k = (t >> 4) & 31, h = t & 15;
        float a[16];
#pragma unroll
        for (int e = 0; e < 16; ++e) a[e] = 0.f;
        for (int p = 0; p < 64; ++p) {
            const f32x2 cc = Cc[(d * 16 + h) * 65 + p], ee = E[(d * 64 + p) * 33 + k];
            const float cr = cc.x * ee.x - cc.y * ee.y, ci = cc.x * ee.y + cc.y * ee.x;
            const LAS f32x4* bp = (const LAS f32x4*)(Bb + (d * 64 + p) * 16);
#pragma unroll
            for (int e = 0; e < 8; ++e) { const f32x4 b2 = bp[e]; a[2 * e] += cr * b2[0] - ci * b2[1]; a[2 * e + 1] += cr * b2[2] - ci * b2[3]; }
        }
        LAS f32x4* kp = (LAS f32x4*)(Kt + ((d * 32 + k) * 16 + h) * 16);
#pragma unroll
        for (int e = 0; e < 4; ++e) kp[e] = (f32x4){a[4 * e], a[4 * e + 1], a[4 * e + 2], a[4 * e + 3]};
    }
    __syncthreads();
    h16* W2 = (h16*)(P.ws + WS_W2S) + (size_t)g * 512 * 768;
    for (int idx = qt * 12288 + tid; idx < (qt + 1) * 12288; idx += 512) {
        const int n = idx / 96, kc = idx % 96, k0 = 8 * kc, s = n >> 4, h = n & 15;
        float v[8];
        if (k0 < 512) {
            const int sp = k0 >> 4, hp0 = k0 & 15;
#pragma unroll
            for (int e = 0; e < 8; ++e) {
                const int hp = hp0 + e; float val;
                if (sp < s) val = Kt[((0 * 32 + (s - sp)) * 16 + h) * 16 + hp];
                else if (sp > s) val = Kt[((1 * 32 + (sp - s)) * 16 + h) * 16 + hp];
                else { val = Kt[((0 * 32) * 16 + h) * 16 + hp] + Kt[((1 * 32) * 16 + h) * 16 + hp]; if (hp == h) val += P.ssm_d[g * 16 + h]; }
                v[e] = val;
            }
        } else {
            const int kk0 = k0 - 512, d = kk0 >> 7, p0 = (kk0 >> 1) & 63; const int ke = d == 0 ? s + 1 : 32 - s;
#pragma unroll
            for (int e = 0; e < 4; ++e) {
                const f32x2 cc = Cc[(d * 16 + h) * 65 + p0 + e], ee = E[(d * 64 + p0 + e) * 33 + ke];
                v[2 * e] = cc.x * ee.x - cc.y * ee.y; v[2 * e + 1] = -(cc.x * ee.y + cc.y * ee.x);
            }
        }
        u32x4 o; o.x = pk2(v[0], v[1]); o.y = pk2(v[2], v[3]); o.z = pk2(v[4], v[5]); o.w = pk2(v[6], v[7]);
        *(u32x4*)(W2 + (size_t)n * 768 + k0) = o;
    }
    h16* W1 = (h16*)(P.ws + WS_W1S) + (size_t)g * 256 * 512;
    for (int idx = qt * 4096 + tid; idx < (qt + 1) * 4096; idx += 512) {
        const int n = idx >> 6, k0 = 8 * (idx & 63), d = n >> 7, p = (n >> 1) & 63, ri = n & 1, sp = k0 >> 4, hp0 = k0 & 15;
        const f32x2 ee = E[(d * 64 + p) * 33 + (d == 0 ? 31 - sp : sp)];
        float v[8];
#pragma unroll
        for (int e = 0; e < 8; ++e) { const f32x2 bb = Bb[(d * 64 + p) * 16 + hp0 + e]; v[e] = ri == 0 ? (ee.x * bb.x - ee.y * bb.y) : (ee.x * bb.y + ee.y * bb.x); }
        u32x4 o; o.x = pk2(v[0], v[1]); o.y = pk2(v[2], v[3]); o.z = pk2(v[4], v[5]); o.w = pk2(v[6], v[7]);
        *(u32x4*)(W1 + (size_t)n * 512 + k0) = o;
    }
    __syncthreads();
}

__device__ __forceinline__ void norm_row_h16(const float* xrow, const float* gvec, const float* modrow, h16* orow, int lane) {
    const f32x4* xr = (const f32x4*)xrow + lane; f32x4 v[4]; float s = 0.f;
#pragma unroll
    for (int j = 0; j < 4; ++j) { v[j] = xr[64 * j]; s += (v[j][0] * v[j][0] + v[j][1] * v[j][1]) + (v[j][2] * v[j][2] + v[j][3] * v[j][3]); }
    const float rstd = 1.0f / sqrtf(wave_sum(s) * (1.0f / DM) + EPS);
    u32x2* o8 = (u32x2*)orow + lane;
#pragma unroll
    for (int j = 0; j < 4; ++j) { const f32x4 gg = ((const f32x4*)gvec)[lane + 64 * j], sc = ((const f32x4*)(modrow + 1024))[lane + 64 * j], sh = ((const f32x4*)modrow)[lane + 64 * j];
        const f32x4 w = v[j] * rstd * gg * (sc + 1.0f) + sh; u32x2 o; o.x = pk2(w[0], w[1]); o.y = pk2(w[2], w[3]); o8[64 * j] = o; }
}

__device__ __forceinline__ void scan_phase(const Params& P) {
    const int gid = blockIdx.x * 512 + threadIdx.x;
    const int nthr = gridDim.x * 512;
    const float* __restrict__ S = (const float*)(P.ws + WS_X1);
    h16* __restrict__ UH = (h16*)(P.ws + WS_UH);
    for (int id = gid; id < NB * 64 * 2 * 64; id += nthr) {
        const int p = id & 63, d = (id >> 6) & 1, g = (id >> 7) & 63, b = id >> 13;
        const float dt = expf(P.log_dt[d * 64 + g]); const float ar = P.a_re[(d * 64 + g) * 64 + p], ai = P.a_im[(d * 64 + g) * 64 + p];
        const float mg = expf(ar * dt * (float)TCH), an = ai * dt * (float)TCH; const float tr = mg * cosf(an), ti = mg * sinf(an);
        float hr = 0.f, hi = 0.f;
        const size_t colS = (size_t)d * 128 + 2 * p, colH = 512 + (size_t)d * 128 + 2 * p;
        for (int q = 0; q < 8; ++q) {
            const int cc = d == 0 ? q : 7 - q; const size_t row = (size_t)g * NCHP + 2048 + b * 8 + cc;
            const f32x2 sv = *(const f32x2*)(S + row * 256 + colS);
            *(unsigned*)(UH + row * UHW + colH) = pk2(hr, hi);
            const float nr = tr * hr - ti * hi + sv.x, ni = tr * hi + ti * hr + sv.y; hr = nr; hi = ni;
        }
        for (int q0 = 0; q0 < 256; q0 += 8) {
            f32x2 sv[8];
#pragma unroll
            for (int e = 0; e < 8; ++e) { const int cq = d == 0 ? q0 + e : 255 - q0 - e; sv[e] = *(const f32x2*)(S + ((size_t)g * NCHP + b * 256 + cq) * 256 + colS); }
#pragma unroll
            for (int e = 0; e < 8; ++e) {
                const int cq = d == 0 ? q0 + e : 255 - q0 - e; const size_t row = (size_t)g * NCHP + b * 256 + cq;
                *(unsigned*)(UH + row * UHW + colH) = pk2(hr, hi);
                const float nr = tr * hr - ti * hi + sv[e].x, ni = tr * hi + ti * hr + sv[e].y; hr = nr; hi = ni;
            }
        }
    }
}

__device__ __forceinline__ int attn_crow(int r, int hi) { return (r & 3) + 8 * (r >> 2) + 4 * hi; }
template <bool ADDC>
__device__ __forceinline__ void attn_units(const Params& P, LAS unsigned char* lds, const float cadd) {
    int tid = threadIdx.x; asm volatile("" : "+v"(tid));
    const int lane = tid & 63, wid = __builtin_amdgcn_readfirstlane(tid >> 6), r32 = lane & 31, hi = lane >> 5;
    const h16* Q = (const h16*)(P.ws + WS_UH); const h16* Kb = (const h16*)(P.ws + WS_K); const h16* Vt = (const h16*)(P.ws + WS_VT);
    const h16* Z = (const h16*)(P.ws + WS_BUFZ); h16* OG = (h16*)(P.ws + WS_BUFA);
    LAS float* lsc = (LAS float*)(lds + 131072) + wid * 64;
    const int drow = 8 * wid + (lane >> 3), dchk = (lane & 7) ^ ((drow >> 1) & 7);
    const unsigned kdoff = (unsigned)(drow * 128 + dchk * 16), vdoff = (unsigned)((drow * KVL + dchk * 8) * 2);
    int kro[2], krx[2], vro[2], vrx[2];
#pragma unroll
    for (int kh = 0; kh < 2; ++kh) {
        const int i = r32 & 15; const int pr = (r32 & 16) | (i & 3) | ((i & 4) << 1) | ((i & 8) >> 1);
        const int row = 32 * kh + pr; kro[kh] = row * 128; krx[kh] = (row >> 1) & 7;
        const int dr = 32 * kh + r32; vro[kh] = dr * 128; vrx[kh] = (dr >> 1) & 7;
    }
    const f32x16 zero16 = {0.f, 0.f, 0.f, 0.f, 0.f, 0.f, 0.f, 0.f, 0.f, 0.f, 0.f, 0.f, 0.f, 0.f, 0.f, 0.f};
    for (int u = blockIdx.x; u < 2048; u += gridDim.x) {
        const int xx = u & 7, jj = u >> 3, bg = xx + 8 * (jj >> 6), qblk = jj & 63;
        const int b = bg >> 2, g = bg & 3, hh = 4 * g + (wid & 3), tok = qblk * 128 + (wid >> 2) * 64;
        h16x8 qr[2][4];
#pragma unroll
        for (int rb = 0; rb < 2; ++rb) { const h16* qp = Q + ((size_t)(b * SEQ + tok + 32 * rb + r32)) * DM + hh * 64 + hi * 8;
#pragma unroll
            for (int d0 = 0; d0 < 4; ++d0) qr[rb][d0] = *(const h16x8*)(qp + 16 * d0); }
        const char* kbase = (const char*)(Kb + (size_t)bg * KVL * 64);
        const char* vbase = (const char*)(Vt + (size_t)bg * 64 * KVL);
        f32x16 o00 = zero16, o01 = zero16, o10 = zero16, o11 = zero16;
        float lsum0 = 0.f, lsum1 = 0.f;
#define ATT_DMA(sg_, slot_) do { const int t0_ = 4 * (sg_); LAS unsigned char* d_ = lds + (slot_) * 65536 + wid * 1024; \
        _Pragma("unroll 1") for (int q_ = 0; q_ < 4; ++q_) { \
            __builtin_amdgcn_global_load_lds((const unsigned*)(kbase + (size_t)(t0_ + q_) * 8192 + kdoff), (LAS unsigned*)(d_ + q_ * 8192), 16, 0, 0); \
            __builtin_amdgcn_global_load_lds((const unsigned*)(vbase + (size_t)(t0_ + q_) * 128 + vdoff), (LAS unsigned*)(d_ + 32768 + q_ * 8192), 16, 0, 0); } } while (0)
        ATT_DMA(0, 0);
#pragma unroll
        for (int rb = 0; rb < 2; ++rb)
#pragma unroll
            for (int d0 = 0; d0 < 4; ++d0) asm volatile("" :: "v"(qr[rb][d0]));
        asm volatile("s_waitcnt vmcnt(0)" ::: "memory"); __builtin_amdgcn_s_barrier(); asm volatile("" ::: "memory");
        for (int sg = 0; sg < 33; ++sg) {
            const int slot = sg & 1;
            if (wid & 4) __builtin_amdgcn_s_sleep(6);
            if (sg + 1 < 33) ATT_DMA(sg + 1, slot ^ 1);
#pragma unroll 1
            for (int j = 0; j < 4; ++j) {
                const LAS unsigned char* kb = lds + slot * 65536 + j * 8192; const LAS unsigned char* vb = kb + 32768;
                f32x16 s00, s01, s10, s11;
#pragma unroll
                for (int d0 = 0; d0 < 4; ++d0) {
                    const h16x8 a0 = *(const LAS h16x8*)(kb + kro[0] + (((2 * d0 + hi) ^ krx[0]) << 4));
                    const h16x8 a1 = *(const LAS h16x8*)(kb + kro[1] + (((2 * d0 + hi) ^ krx[1]) << 4));
                    s00 = __builtin_amdgcn_mfma_f32_32x32x16_f16(a0, qr[0][d0], d0 == 0 ? zero16 : s00, 0, 0, 0);
                    s10 = __builtin_amdgcn_mfma_f32_32x32x16_f16(a0, qr[1][d0], d0 == 0 ? zero16 : s10, 0, 0, 0);
                    s01 = __builtin_amdgcn_mfma_f32_32x32x16_f16(a1, qr[0][d0], d0 == 0 ? zero16 : s01, 0, 0, 0);
                    s11 = __builtin_amdgcn_mfma_f32_32x32x16_f16(a1, qr[1][d0], d0 == 0 ? zero16 : s11, 0, 0, 0);
                }
#pragma unroll
                for (int ks = 0; ks < 4; ++ks) {
                    float p0[8], p1[8];
#pragma unroll
                    for (int e = 0; e < 8; ++e) {
                        float v0 = ks < 2 ? s00[8 * (ks & 1) + e] : s01[8 * (ks & 1) + e];
                        float v1 = ks < 2 ? s10[8 * (ks & 1) + e] : s11[8 * (ks & 1) + e];
                        if (ADDC) { v0 += cadd; v1 += cadd; }
                        p0[e] = __builtin_amdgcn_exp2f(v0); p1[e] = __builtin_amdgcn_exp2f(v1);
                    }
                    lsum0 += ((p0[0] + p0[1]) + (p0[2] + p0[3])) + ((p0[4] + p0[5]) + (p0[6] + p0[7]));
                    lsum1 += ((p1[0] + p1[1]) + (p1[2] + p1[3])) + ((p1[4] + p1[5]) + (p1[6] + p1[7]));
                    u32x4 w0, w1;
                    w0.x = pk2(p0[0], p0[1]); w0.y = pk2(p0[2], p0[3]); w0.z = pk2(p0[4], p0[5]); w0.w = pk2(p0[6], p0[7]);
                    w1.x = pk2(p1[0], p1[1]); w1.y = pk2(p1[2], p1[3]); w1.z = pk2(p1[4], p1[5]); w1.w = pk2(p1[6], p1[7]);
                    const h16x8 pa0 = __builtin_bit_cast(h16x8, w0), pa1 = __builtin_bit_cast(h16x8, w1);
                    const h16x8 b0 = *(const LAS h16x8*)(vb + vro[0] + (((2 * ks + hi) ^ vrx[0]) << 4));
                    const h16x8 b1 = *(const LAS h16x8*)(vb + vro[1] + (((2 * ks + hi) ^ vrx[1]) << 4));
                    o00 = __builtin_amdgcn_mfma_f32_32x32x16_f16(pa0, b0, o00, 0, 0, 0);
                    o10 = __builtin_amdgcn_mfma_f32_32x32x16_f16(pa1, b0, o10, 0, 0, 0);
                    o01 = __builtin_amdgcn_mfma_f32_32x32x16_f16(pa0, b1, o01, 0, 0, 0);
                    o11 = __builtin_amdgcn_mfma_f32_32x32x16_f16(pa1, b1, o11, 0, 0, 0);
                }
            }
            asm volatile("s_waitcnt vmcnt(0) lgkmcnt(0)" ::: "memory"); __builtin_amdgcn_s_barrier(); asm volatile("" ::: "memory");
        }
        lsum0 += __shfl_xor(lsum0, 32); lsum1 += __shfl_xor(lsum1, 32);
        if (hi == 0) { lsc[r32] = lsum0; lsc[32 + r32] = lsum1; }
        __builtin_amdgcn_s_waitcnt(0xc07f);
        asm volatile("" ::: "memory");
#pragma unroll
        for (int r = 0; r < 16; ++r) {
            const int q = attn_crow(r, hi); const float li0 = 1.0f / lsc[q], li1 = 1.0f / lsc[32 + q];
            const size_t off0 = ((size_t)(b * SEQ + tok + q)) * DM + hh * 64 + r32, off1 = off0 + (size_t)32 * DM;
            OG[off0] = (h16)(o00[r] * li0 * (float)Z[off0]); OG[off0 + 32] = (h16)(o01[r] * li0 * (float)Z[off0 + 32]);
            OG[off1] = (h16)(o10[r] * li1 * (float)Z[off1]); OG[off1 + 32] = (h16)(o11[r] * li1 * (float)Z[off1 + 32]);
        }
    }
}
__device__ __forceinline__ void attn_phase(const Params& P, LAS unsigned char* lds) {
    const int lane = threadIdx.x & 63;
    const float mq = wave_max(fabsf(P.q_norm[lane])), mk = wave_max(fabsf(P.k_norm[lane]));
    const float M = 8.0f * mq * mk;
    if (M <= 10.5f) attn_units<false>(P, lds, 0.f);
    else attn_units<true>(P, lds, -((M - 10.5f) * LOG2E));
}

constexpr size_t WS_BAR = 640 * 1024;
#define XB_TMO      128
#define XB_XCNT(j)  (256  + 64 * (j))
#define XB_XSUB(j)  (1280 + 64 * (j))
#define XB_XGEN(j)  (2304 + 64 * (j))
#define XB_TOP      3328
#define XB_TOPGEN   3392
#define XCD_BAR_WORDS 3456
#define XB_SPIN_CAP (1u << 18)
__device__ __forceinline__ unsigned xb_ld(unsigned* p)              { return __hip_atomic_load(p, __ATOMIC_RELAXED, __HIP_MEMORY_SCOPE_AGENT); }
__device__ __forceinline__ unsigned xb_add(unsigned* p, unsigned v) { return __hip_atomic_fetch_add(p, v, __ATOMIC_RELAXED, __HIP_MEMORY_SCOPE_AGENT); }
__device__ __forceinline__ unsigned xb_xcc_id() { return (unsigned)__builtin_amdgcn_s_getreg((3 << 11) | 20) & 0xFu; }
#define XB_SPIN(cond, bar) do { unsigned _sp = 0; while (cond) { __builtin_amdgcn_s_sleep(1); \
    if ((++_sp & 255u) == 0u) { if (xb_ld(&(bar)[XB_TMO])) break; if (_sp > XB_SPIN_CAP) { atomicAdd(&(bar)[XB_TMO], 1u); break; } } } } while (0)
struct XcdBarrier { unsigned* bar; unsigned x; volatile LAS unsigned* st; };
__device__ __forceinline__ XcdBarrier xcd_barrier_post(unsigned* bar, volatile LAS unsigned* st) {
    XcdBarrier b; b.bar = bar; b.x = xb_xcc_id(); b.st = st;
    if (threadIdx.x == 0) (void)xb_add(&bar[XB_XCNT(b.x)], 1u);
    return b;
}
__device__ __forceinline__ void xcd_barrier_complete(unsigned* bar, unsigned x, unsigned& nloc, unsigned& nx) {
    const unsigned G = gridDim.x * gridDim.y * gridDim.z;
    unsigned sum, cnt, mine, sp = 0u;
    for (;;) {
        sum = 0u; cnt = 0u; mine = 0u;
#pragma unroll
        for (unsigned j = 0; j < 16; ++j) { const unsigned c = xb_ld(&bar[XB_XCNT(j)]); sum += c; cnt += (c > 0u) ? 1u : 0u; mine = (j == x) ? c : mine; }
        if (sum == G) break;
        __builtin_amdgcn_s_sleep(1);
        if ((++sp & 255u) == 0u) { if (xb_ld(&bar[XB_TMO])) break; if (sp > XB_SPIN_CAP) { atomicAdd(&bar[XB_TMO], 1u); break; } }
    }
    nloc = mine > 0u ? mine : 1u; nx = cnt > 0u ? cnt : 1u;
}
__device__ __forceinline__ void xcd_barrier(const XcdBarrier& b) {
    asm volatile("s_waitcnt vmcnt(0)" ::: "memory");
    __syncthreads();
    if (threadIdx.x == 0) {
        unsigned* bar = b.bar;
        __builtin_amdgcn_s_waitcnt(0);
        unsigned nloc = b.st[0], nx = b.st[1];
        if (nloc == 0u) { xcd_barrier_complete(bar, b.x, nloc, nx); b.st[0] = nloc; b.st[1] = nx; }
        const unsigned old = xb_add(&bar[XB_XSUB(b.x)], 1u);
        const unsigned gen = old / nloc;
        if (old + 1u == (gen + 1u) * nloc) {
            __builtin_amdgcn_fence(__ATOMIC_RELEASE, "agent");
            asm volatile("s_waitcnt vmcnt(0)" ::: "memory");
            const unsigned og = xb_add(&bar[XB_TOP], 1u);
            const unsigned tg = og / nx;
            if (og + 1u == (tg + 1u) * nx) xb_add(&bar[XB_TOPGEN], 1u);
            else XB_SPIN(xb_ld(&bar[XB_TOPGEN]) == tg, bar);
            __builtin_amdgcn_fence(__ATOMIC_ACQUIRE, "agent");
            xb_add(&bar[XB_XGEN(b.x)], 1u);
            asm volatile("s_waitcnt vmcnt(0)" ::: "memory");
        } else {
            XB_SPIN(xb_ld(&bar[XB_XGEN(b.x)]) == gen, bar);
            __builtin_amdgcn_fence(__ATOMIC_ACQUIRE, "agent");
            asm volatile("s_waitcnt vmcnt(0)" ::: "memory");
        }
    }
    __syncthreads();
}

__global__ void __launch_bounds__(512) fwd_megakernel(Params P) {
    extern __shared__ __attribute__((aligned(16))) unsigned char lds_raw[];
    LAS unsigned char* lds = (LAS unsigned char*)lds_raw;
    cg::grid_group grid = cg::this_grid();
    const int G = gridDim.x, bx = blockIdx.x;
    unsigned char* ws = P.ws;
    float* MOD = (float*)(ws + WS_MOD);
#define THREAD_IDS int tid = threadIdx.x; asm volatile("" : "+v"(tid)); const int lane = tid & 63, wave = __builtin_amdgcn_readfirstlane(tid >> 6); const int gw = bx * 8 + wave, NGW = G * 8; LAS float* scr = (LAS float*)(lds + wave * 16384); (void)scr; (void)lane; (void)gw; (void)NGW; (void)tid;

    volatile LAS unsigned* bst = (volatile LAS unsigned*)(lds + LDS_BYTES - 64);
    if (threadIdx.x == 0) { bst[0] = 0u; bst[1] = 0u; }
    if (bx == 0) for (int i = threadIdx.x; i < XCD_BAR_WORDS; i += 512) ((unsigned*)(ws + WS_BAR))[i] = 0u;
    for (int t = bx; t < 256; t += G) s5_tables(P, t >> 2, t & 3, lds);
    {   THREAD_IDS
        if (bx == G - 1) for (int idx = tid; idx < 2048; idx += 512) {
            const int pos = idx >> 4, i = idx & 15; const float fr = powf(10000.0f, -(float)i / 16.0f); const float an = (float)pos * fr;
            ((float*)(ws + WS_ROPEC))[idx] = cosf(an); ((float*)(ws + WS_ROPES))[idx] = sinf(an);
        }
        for (int t = gw; t < 2 * 768; t += NGW) { const int l = t / 768, n4 = t % 768;
            gemv9_task<0>(P, P.w_mod + (size_t)l * DM * 3072, 3072, 4 * n4, nullptr, MOD + l * 9 * 3072, 3072, 4 * n4, P.b_mod + l * 3072, lane); }
        for (int it = gw; it < 1024 + 1280 + 3 * 512; it += NGW) {
            if (it < 1024) tr_plain_item<false>(P.ssm_w_in, 2048, (h16*)(ws + WS_WB0), scr, it, lane);
            else if (it < 2304) tr_plain_item<true>(P.attn_w_in, 2560, (h16*)(ws + WS_WB1), scr, it - 1024, lane);
            else { const int w = (it - 2304) / 512, r = (it - 2304) % 512;
                const float* src = w == 0 ? P.w_glu : (w == 1 ? P.ssm_w_out : P.attn_w_out); h16* dst = (h16*)(ws + (w == 0 ? WS_WGLU : (w == 1 ? WS_WOUT0 : WS_WOUT1)));
                tr_plain_item<false>(src, 1024, dst, scr, r, lane); }
        }
    }
    grid.sync();
    (void)xcd_barrier_post((unsigned*)(ws + WS_BAR), bst);
#define GRID_BAR() do { XcdBarrier xb_; xb_.bar = (unsigned*)(P.ws + WS_BAR); xb_.x = xb_xcc_id(); xb_.st = (volatile LAS unsigned*)(lds + LDS_BYTES - 64); xcd_barrier(xb_); } while (0)
    {   THREAD_IDS
        h16* XN = (h16*)(ws + WS_BUFA);
        for (int m = gw; m < MTOT; m += NGW) { const float* xr = m < NTOK ? P.x + (size_t)m * DM : P.ctx + (size_t)(m - NTOK) * DM;
            norm_row_h16(xr, P.norm_g, MOD + (m < NTOK ? (m >> 13) : 8) * 3072, XN + (size_t)m * DM, lane); }
        for (int t = gw; t < 640; t += NGW) { const int np = 4 * t; gemv9_task<1>(P, P.attn_w_in, 2560, attn_srccol(np), MOD + 9 * 3072, (float*)(ws + WS_BIAS1), 2560, np, nullptr, lane); }
        for (int i = bx * 512 + tid; i < 9 * 1024; i += G * 512) { const int bs = i >> 10, k = i & 1023; ((float*)(ws + WS_BIAS0))[i] = P.norm_g[DM + k] * (1.0f + MOD[9 * 3072 + bs * 3072 + 1024 + k]); }
    }
    GRID_BAR();
    {
        pg8::Gemm g{(const h16*)(ws + WS_BUFA), (const h16*)(ws + WS_WB0), 1024, 1024, 1024};
        pg8::SchedPlain S; S.init(MTOT, 2048, G, bx, 1024, 1024, 0);
        EpiSsmIn E{(h16*)(ws + WS_UH), (h16*)(ws + WS_BUFZ)};
        pg8::gemm_phase(lds, g, S, E);
    }
    GRID_BAR();
    {
        pg8::Gemm g{(const h16*)(ws + WS_UH), (const h16*)(ws + WS_W1S), UHW, 512, 512};
        pg8::SchedGrouped S; S.init(NCHP, 256, 64, G, bx, UHW, 512, (size_t)NCHP * UHW, (size_t)256 * 512);
        EpiS5State E{(float*)(ws + WS_X1)};
        pg8::gemm_phase(lds, g, S, E);
    }
    GRID_BAR();
    scan_phase(P);
    GRID_BAR();
    {
        pg8::Gemm g{(const h16*)(ws + WS_UH), (const h16*)(ws + WS_W2S), UHW, 768, 768};
        pg8::SchedGrouped S; S.init(NCHP, 512, 64, G, bx, UHW, 768, (size_t)NCHP * UHW, (size_t)512 * 768);
        EpiS5Out E{(h16*)(ws + WS_BUFA)};
        pg8::gemm_phase(lds, g, S, E);
    }
    GRID_BAR();
    {
        pg8::Gemm g{(const h16*)(ws + WS_BUFA), (const h16*)(ws + WS_WGLU), 1024, 1024, 1024};
        pg8::SchedPlain S; S.init(MTOT, 1024, G, bx, 1024, 1024, 0);
        EpiGlu E{(const h16*)(ws + WS_BUFA), (const h16*)(ws + WS_BUFZ), P.b_glu, (h16*)(ws + WS_UH)};
        pg8::gemm_phase(lds, g, S, E);
    }
    GRID_BAR();
    {
        pg8::Gemm g{(const h16*)(ws + WS_UH), (const h16*)(ws + WS_WOUT0), 1024, 1024, 1024};
        pg8::SchedPlain S; S.init(MTOT, 1024, G, bx, 1024, 1024, 0);
        EpiOut<false> E{P.x, P.ctx, nullptr, MOD + 2048, (h16*)(ws + WS_X1), (h16*)(ws + WS_BUFA), (const float*)(ws + WS_BIAS0), (float*)(ws + WS_SSQ1)};
        pg8::gemm_phase(lds, g, S, E);
    }
    GRID_BAR();
    {
        pg8::Gemm g{(const h16*)(ws + WS_BUFA), (const h16*)(ws + WS_WB1), 1024, 1024, 1024};
        pg8::SchedPlain S; S.init(MTOT, 2560, G, bx, 1024, 1024, 0);
        EpiAttnIn E{(const float*)(ws + WS_SSQ1), (const float*)(ws + WS_BIAS1), P.q_norm, P.k_norm, (const float*)(ws + WS_ROPEC), (const float*)(ws + WS_ROPES),
                    (h16*)(ws + WS_UH), (h16*)(ws + WS_K), (h16*)(ws + WS_VT), (h16*)(ws + WS_BUFZ)};
        pg8::gemm_phase(lds, g, S, E);
    }
    GRID_BAR();
    attn_phase(P, lds);
    GRID_BAR();
    {
        pg8::Gemm g{(const h16*)(ws + WS_BUFA), (const h16*)(ws + WS_WOUT1), 1024, 1024, 1024};
        pg8::SchedPlain S; S.init(NTOK, 1024, G, bx, 1024, 1024, 0);
        EpiOut<true> E{nullptr, nullptr, (const h16*)(ws + WS_X1), MOD + 9 * 3072 + 2048, (h16*)(ws + WS_UH), nullptr, nullptr, (float*)(ws + WS_SSQ2)};
        pg8::gemm_phase(lds, g, S, E);
    }
    GRID_BAR();
    {   THREAD_IDS
        const float* __restrict__ ssq = (const float*)(ws + WS_SSQ2);
        const h16* __restrict__ X2 = (const h16*)(ws + WS_UH);
        float* __restrict__ outp = P.out;
        f32x4 gg[4];
#pragma unroll
        for (int j = 0; j < 4; ++j) gg[j] = ((const f32x4*)P.final_g)[lane + 64 * j];
        for (int m = gw; m < NTOK; m += NGW) {
            const f32x4 s0 = *(const f32x4*)(ssq + (size_t)m * 16), s1 = *(const f32x4*)(ssq + (size_t)m * 16 + 4), s2 = *(const f32x4*)(ssq + (size_t)m * 16 + 8), s3 = *(const f32x4*)(ssq + (size_t)m * 16 + 12);
            const h16x4* xi = (const h16x4*)(X2 + (size_t)m * DM) + lane;
            f32x4 v[4];
#pragma unroll
            for (int j = 0; j < 4; ++j) { const h16x4 w = xi[64 * j]; v[j] = (f32x4){(float)w[0], (float)w[1], (float)w[2], (float)w[3]}; }
            const f32x4 st = (s0 + s1) + (s2 + s3);
            const float rstd = 1.0f / sqrtf(((st[0] + st[1]) + (st[2] + st[3])) * (1.0f / DM) + EPS);
            f32x4* o = (f32x4*)(outp + (size_t)m * DM) + lane;
#pragma unroll
            for (int j = 0; j < 4; ++j) o[64 * j] = v[j] * rstd * gg[j];
        }
    }
}

extern "C" void kernel_launch(void* const* d_in, const int* in_sizes, int n_in, void* d_out, int out_size, void* d_ws, size_t ws_size, hipStream_t stream) {
    static int grid_blocks = 0;
    if (grid_blocks == 0) {
        if (n_in != 24 || ws_size < WS_END) { fprintf(stderr, "kernel_launch: unexpected inputs (n_in %d, ws %zu)\n", n_in, ws_size); grid_blocks = -1; return; }
        int dev = 0, cus = 0, per_cu = 0;
        hipGetDevice(&dev);
        hipDeviceGetAttribute(&cus, hipDeviceAttributeMultiprocessorCount, dev);
        hipFuncSetAttribute((const void*)fwd_megakernel, hipFuncAttributeMaxDynamicSharedMemorySize, LDS_BYTES);
        hipOccupancyMaxActiveBlocksPerMultiprocessor(&per_cu, (const void*)fwd_megakernel, 512, LDS_BYTES);
        if (per_cu < 1) per_cu = 1;
        grid_blocks = cus * per_cu;
        (void)hipGetLastError();
    }
    if (grid_blocks < 0) return;
    Params p{};
    const float** pp = (const float**)&p;
    for (int i = 0; i < 24; ++i) pp[i] = (const float*)d_in[i];
    p.out = (float*)d_out; p.ws = (unsigned char*)d_ws;
    void* args[] = {&p};
    hipError_t e = hipLaunchCooperativeKernel((const void*)fwd_megakernel, dim3(grid_blocks), dim3(512), args, LDS_BYTES, stream);
    if (e != hipSuccess) fprintf(stderr, "cooperative launch failed: %s (grid %d)\n", hipGetErrorString(e), grid_blocks);
}
```
